# Optimizing an MI355X kernel written in HIP

```python
import jax
import jax.numpy as jnp
from jax import lax
import numpy as np

D_MODEL = 1024
BATCH = 2
SEQ = 8192
DEPTH = 2

GRID_W = 64
CTX_LEN = 256
N_EVEN = (DEPTH + 1) // 2
N_ODD = DEPTH // 2
N_MOD = 9
D_FF = 2816
D_POOL = D_MODEL // 4
POOL_WINDOWS = (2, 4, 8, 16)
N_POOL_GROUPS = len(POOL_WINDOWS)
POOL_GROUP_DIM = D_POOL // N_POOL_GROUPS
D_HGRN = D_MODEL - D_POOL
HGRN_HEAD_DIM = 128
N_HGRN_HEADS = D_HGRN // HGRN_HEAD_DIM
HGRN_CHUNK = 64
D_IN_AB = D_POOL + 5 * D_HGRN
D_GMLP = D_MODEL
GMLP_CHUNK = 128
GMLP_GROUP_DIM = 128
N_GMLP_GROUPS = D_GMLP // GMLP_GROUP_DIM
EPS = 1e-6

kernel_name = 'hybrid_pool_hgrn2_gmlp_macaron_dit'


def rms_norm(x, g):
    xf = x.astype(jnp.float32)
    y = xf * lax.rsqrt(jnp.mean(xf * xf, axis=-1, keepdims=True) + EPS)
    return (y * g.astype(jnp.float32)).astype(x.dtype)


def layer_norm(x, g, b):
    xf = x.astype(jnp.float32)
    xc = xf - jnp.mean(xf, axis=-1, keepdims=True)
    y = xc * lax.rsqrt(jnp.mean(xc * xc, axis=-1, keepdims=True) + EPS)
    return (y * g.astype(jnp.float32) + b.astype(jnp.float32)).astype(x.dtype)


def adaln(x, g, mod, s):
    return rms_norm(x, g) * (1 + mod[:, :, 3 * s + 1]) + mod[:, :, 3 * s]


def gate_of(mod, s):
    return mod[:, :, 3 * s + 2]


def swiglu(h, w1, w3, w2):
    return (jax.nn.silu(h @ w1) * (h @ w3)) @ w2


def centred_mean(x, w):
    L = x.shape[-2]
    cs = jnp.cumsum(x.astype(jnp.float32), axis=-2)
    cs = jnp.concatenate([jnp.zeros_like(cs[..., :1, :]), cs], axis=-2)
    t = jnp.arange(L)
    lo = jnp.clip(t - w // 2, 0, L)
    hi = jnp.clip(t - w // 2 + w, 0, L)
    total = jnp.take(cs, hi, axis=-2) - jnp.take(cs, lo, axis=-2)
    count = (hi - lo).astype(jnp.float32)[:, None]
    return (total / count).astype(x.dtype)


def pool_mixer(xa, w_pool, scale, on_grid):
    B, L, _ = xa.shape
    if on_grid:
        rows = L // GRID_W
        xr = xa.reshape(B, rows, GRID_W, D_POOL)
    else:
        xr = xa
    groups = jnp.split(xr, N_POOL_GROUPS, axis=-1)
    y = jnp.stack([centred_mean(g, w) - g for g, w in zip(groups, POOL_WINDOWS)], axis=-2)
    y = jnp.einsum('...gc,gcd->...gd', y, w_pool)
    return y.reshape(B, L, D_POOL) * scale


def split_heads(a):
    B, L, _ = a.shape
    return a.reshape(B, L, N_HGRN_HEADS, HGRN_HEAD_DIM).transpose(0, 2, 1, 3).astype(jnp.float32)


def hgrn_prep(p, lb):
    q, v, f_fwd, f_bwd, g = jnp.split(p, 5, axis=-1)
    q = split_heads(jax.nn.silu(q)) * (HGRN_HEAD_DIM ** -0.5)
    v = split_heads(v)
    dirs = []
    for f, lbd in ((f_fwd, lb[0]), (f_bwd, lb[1])):
        lbh = lbd.astype(jnp.float32).reshape(1, N_HGRN_HEADS, 1, HGRN_HEAD_DIM)
        forget = lbh + (1 - lbh) * jax.nn.sigmoid(split_heads(f))
        dirs.append((1 - forget, jnp.log(forget)))
    return q, v, dirs, g


def hgrn_chunk_scan(q, k, v, logf, s0):
    B, H, L, _ = q.shape
    n = L // HGRN_CHUNK

    def to_chunks(a):
        return jnp.moveaxis(a.reshape(B, H, n, HGRN_CHUNK, a.shape[-1]), 2, 0)

    mask = jnp.tril(jnp.ones((HGRN_CHUNK, HGRN_CHUNK), dtype=bool))[:, :, None]

    def step(S, inp):
        qc, kc, vc, lf = inp
        b = jnp.cumsum(lf, axis=2)
        o_inter = jnp.einsum('bhjk,bhkv->bhjv', qc * jnp.exp(b), S)
        diff = b[:, :, :, None, :] - b[:, :, None, :, :]
        decay = jnp.exp(jnp.where(mask, diff, -jnp.inf))
        a = jnp.einsum('bhjk,bhjik,bhik->bhji', qc, decay, kc)
        o = o_inter + jnp.einsum('bhji,bhiv->bhjv', a, vc)
        b_last = b[:, :, -1:, :]
        S = jnp.exp(b[:, :, -1, :])[..., None] * S + jnp.einsum('bhik,bhiv->bhkv', kc * jnp.exp(b_last - b), vc)
        return S, o

    S, o = lax.scan(step, s0, (to_chunks(q), to_chunks(k), to_chunks(v), to_chunks(logf)))
    o = jnp.moveaxis(o, 0, 2).reshape(B, H, L, v.shape[-1])
    return o, S


def hgrn_readout(o, gate, g_norm, dtype):
    B, H, L, dv = o.shape
    o = o.transpose(0, 2, 1, 3)
    o = o * lax.rsqrt(jnp.mean(o * o, axis=-1, keepdims=True) + EPS)
    o = o.reshape(B, L, D_HGRN) * g_norm.astype(jnp.float32)
    return (o * jax.nn.silu(gate.astype(jnp.float32))).astype(dtype)


def hgrn_mixer(p_lat, p_ctx, lb, g_norm):
    q_l, v_l, dirs_l, gate_l = hgrn_prep(p_lat, lb)
    q_c, v_c, dirs_c, gate_c = hgrn_prep(p_ctx, lb)
    B = p_lat.shape[0]
    s0 = jnp.zeros((B, N_HGRN_HEADS, HGRN_HEAD_DIM, HGRN_HEAD_DIM), jnp.float32)
    o_lat = jnp.zeros_like(v_l)
    o_ctx = jnp.zeros_like(v_c)
    for d, reverse in enumerate((False, True)):
        def flip(a, reverse=reverse):
            return jnp.flip(a, axis=2) if reverse else a
        k_c, lf_c = dirs_c[d]
        k_l, lf_l = dirs_l[d]
        oc, s_ctx = hgrn_chunk_scan(flip(q_c), flip(k_c), flip(v_c), flip(lf_c), s0)
        ol, _ = hgrn_chunk_scan(flip(q_l), flip(k_l), flip(v_l), flip(lf_l), s_ctx)
        o_ctx = o_ctx + flip(oc)
        o_lat = o_lat + flip(ol)
    return (hgrn_readout(o_lat, gate_l, g_norm, p_lat.dtype),
            hgrn_readout(o_ctx, gate_c, g_norm, p_ctx.dtype))


def ab_mixer(h_lat, h_ctx, w_in, w_pool, pool_scale, lb, g_norm, w_out):
    p_lat = h_lat @ w_in
    p_ctx = h_ctx @ w_in
    a_lat = pool_mixer(p_lat[..., :D_POOL], w_pool, pool_scale, True)
    a_ctx = pool_mixer(p_ctx[..., :D_POOL], w_pool, pool_scale, False)
    b_lat, b_ctx = hgrn_mixer(p_lat[..., D_POOL:], p_ctx[..., D_POOL:], lb, g_norm)
    out_lat = jnp.concatenate([a_lat, b_lat], axis=-1) @ w_out
    out_ctx = jnp.concatenate([a_ctx, b_ctx], axis=-1) @ w_out
    return out_lat, out_ctx


def gmlp_mixer(h, w_in, ln_g, ln_b, w_s, b_s, w_out):
    B, L, _ = h.shape
    z = jax.nn.gelu(h @ w_in)
    u, v = jnp.split(z, 2, axis=-1)
    v = layer_norm(v, ln_g, ln_b)
    n = L // GMLP_CHUNK
    vr = v.reshape(B, n, GMLP_CHUNK, N_GMLP_GROUPS, GMLP_GROUP_DIM)
    sv = jnp.einsum('gpq,bnqgc->bnpgc', w_s, vr) + b_s.T[None, None, :, :, None]
    return (u * sv.reshape(B, L, D_GMLP)) @ w_out


def setup_inputs(seed: int = 0) -> dict:
    key = jax.random.key(seed)
    ks = jax.random.split(key, 23)
    D = D_MODEL

    def nrm(k, shape, scale):
        return jax.random.normal(k, shape, jnp.float32) * scale

    return {
        'x': nrm(ks[0], (BATCH, SEQ, D), 1.0),
        'c': nrm(ks[1], (BATCH, D), 1.0),
        'ctx': nrm(ks[2], (BATCH, CTX_LEN, D), 1.0),
        'c_ctx': nrm(ks[3], (D,), 1.0),
        'mod_w': nrm(ks[4], (DEPTH, D, N_MOD * D), 0.5 * D ** -0.5),
        'mod_b': nrm(ks[5], (DEPTH, N_MOD * D), 0.02),
        'norm_g': 1.0 + nrm(ks[6], (DEPTH, 3, D), 0.05),
        'ffn_w1': nrm(ks[7], (DEPTH, 2, D, D_FF), D ** -0.5),
        'ffn_w3': nrm(ks[8], (DEPTH, 2, D, D_FF), D ** -0.5),
        'ffn_w2': nrm(ks[9], (DEPTH, 2, D_FF, D), D_FF ** -0.5),
        'ab_w_in': nrm(ks[10], (N_EVEN, D, D_IN_AB), D ** -0.5),
        'pool_w': nrm(ks[11], (N_EVEN, N_POOL_GROUPS, POOL_GROUP_DIM, POOL_GROUP_DIM), POOL_GROUP_DIM ** -0.5),
        'pool_scale': 1.0 + nrm(ks[12], (N_EVEN, D_POOL), 0.05),
        'hgrn_lb': nrm(ks[13], (N_EVEN + 1, 2, D_HGRN), 1.0),
        'hgrn_norm_g': 1.0 + nrm(ks[14], (N_EVEN, D_HGRN), 0.05),
        'ab_w_out': nrm(ks[15], (N_EVEN, D_POOL + D_HGRN, D), (D_POOL + D_HGRN) ** -0.5),
        'gmlp_w_in': nrm(ks[16], (N_ODD, D, 2 * D_GMLP), D ** -0.5),
        'gmlp_ln_g': 1.0 + nrm(ks[17], (N_ODD, D_GMLP), 0.05),
        'gmlp_ln_b': nrm(ks[18], (N_ODD, D_GMLP), 0.02),
        'gmlp_w_s': nrm(ks[19], (N_ODD, N_GMLP_GROUPS, GMLP_CHUNK, GMLP_CHUNK), GMLP_CHUNK ** -0.5),
        'gmlp_b_s': 1.0 + nrm(ks[20], (N_ODD, N_GMLP_GROUPS, GMLP_CHUNK), 0.05),
        'gmlp_w_out': nrm(ks[21], (N_ODD, D_GMLP, D), D_GMLP ** -0.5),
        'final_g': 1.0 + nrm(ks[22], (D,), 0.05),
    }


def reference(x, c, ctx, c_ctx, mod_w, mod_b, norm_g, ffn_w1, ffn_w3, ffn_w2,
              ab_w_in, pool_w, pool_scale, hgrn_lb, hgrn_norm_g, ab_w_out,
              gmlp_w_in, gmlp_ln_g, gmlp_ln_b, gmlp_w_s, gmlp_b_s, gmlp_w_out, final_g):
    B = x.shape[0]
    lb_all = jnp.cumsum(jax.nn.softmax(hgrn_lb.astype(jnp.float32), axis=0), axis=0)
    xl, xc = x, ctx
    for i in range(DEPTH):
        ctx_live = any(j % 2 == 0 for j in range(i, DEPTH))
        mod_l = (jax.nn.silu(c) @ mod_w[i] + mod_b[i]).reshape(B, 1, N_MOD, D_MODEL)
        mod_c = (jax.nn.silu(c_ctx) @ mod_w[i] + mod_b[i]).reshape(1, 1, N_MOD, D_MODEL)

        xl = xl + 0.5 * gate_of(mod_l, 0) * swiglu(adaln(xl, norm_g[i, 0], mod_l, 0), ffn_w1[i, 0], ffn_w3[i, 0], ffn_w2[i, 0])
        if ctx_live:
            xc = xc + 0.5 * gate_of(mod_c, 0) * swiglu(adaln(xc, norm_g[i, 0], mod_c, 0), ffn_w1[i, 0], ffn_w3[i, 0], ffn_w2[i, 0])

        h_l = adaln(xl, norm_g[i, 1], mod_l, 1)
        if i % 2 == 0:
            e = i // 2
            h_c = adaln(xc, norm_g[i, 1], mod_c, 1)
            o_l, o_c = ab_mixer(h_l, h_c, ab_w_in[e], pool_w[e], pool_scale[e], lb_all[e], hgrn_norm_g[e], ab_w_out[e])
            xc = xc + gate_of(mod_c, 1) * o_c
        else:
            o = i // 2
            o_l = gmlp_mixer(h_l, gmlp_w_in[o], gmlp_ln_g[o], gmlp_ln_b[o], gmlp_w_s[o], gmlp_b_s[o], gmlp_w_out[o])
            if ctx_live:
                h_c = adaln(xc, norm_g[i, 1], mod_c, 1)
                o_c = gmlp_mixer(h_c, gmlp_w_in[o], gmlp_ln_g[o], gmlp_ln_b[o], gmlp_w_s[o], gmlp_b_s[o], gmlp_w_out[o])
                xc = xc + gate_of(mod_c, 1) * o_c
        xl = xl + gate_of(mod_l, 1) * o_l

        xl = xl + 0.5 * gate_of(mod_l, 2) * swiglu(adaln(xl, norm_g[i, 2], mod_l, 2), ffn_w1[i, 1], ffn_w3[i, 1], ffn_w2[i, 1])
        if ctx_live:
            xc = xc + 0.5 * gate_of(mod_c, 2) * swiglu(adaln(xc, norm_g[i, 2], mod_c, 2), ffn_w1[i, 1], ffn_w3[i, 1], ffn_w2[i, 1])
    return rms_norm(xl, final_g)
```

```cpp
#include <hip/hip_runtime.h>
#include <hip/hip_cooperative_groups.h>
#include <cstdio>
namespace cg = cooperative_groups;
namespace pg8 {
#define PG8_LAS __attribute__((address_space(3)))
typedef unsigned short bf16_t;
typedef short bf16x8 __attribute__((ext_vector_type(8)));
typedef float f32x4 __attribute__((ext_vector_type(4)));
typedef unsigned u32x4 __attribute__((ext_vector_type(4)));
constexpr int BM = 256, BK = 64, HALF = 128, HTB = HALF * BK * 2  , STAGE_BYTES = 8 * HTB, NXCD = 8, WGM = 8;

__host__ __device__ __forceinline__ int lds_byte(int r, int c) { const int st = (r >> 4) * 2 + (c >> 5), rr = r & 15, cc = c & 31, ob = rr * 64 + cc * 2; return st * 1024 + (ob ^ (((ob >> 9) & 1) << 5)); }
__host__ __device__ __forceinline__ void stage_rc(int b, int& R, int& C) { const int st = b / 1024, sb = b % 1024, swz = sb ^ (((sb >> 9) & 1) << 5); R = (st >> 1) * 16 + swz / 64; C = (st & 1) * 32 + (swz % 64) / 2; }
__host__ __device__ __forceinline__ int perm32(int rho) { const int n = rho >> 4, i = rho & 15; return 8 * (i >> 2) + 4 * n + (i & 3); }

struct Unit { int pm, pn; };
struct Gemm { const bf16_t* A; const bf16_t* Bt; int M, N, K; };

struct StaticOrder {
    int nM, nN, nwg, G, c;
    __host__ __device__ void init(int M, int N, int G_, int c_) { nM = M / BM; nN = N / BM; nwg = nM * nN; G = G_; c = c_; }
    __host__ __device__ bool next(int i, Unit& u) const {
        const long L = (long)i * G + c; if (L >= nwg) return false;
        int wgid = (int)L; { const int q = nwg / NXCD, r = nwg % NXCD, xcd = wgid % NXCD, off = wgid / NXCD; wgid = (xcd < r ? xcd * (q + 1) : r * (q + 1) + (xcd - r) * q) + off; }
        const int nig = WGM * nN, gid = wgid / nig, fm = gid * WGM, gsz = (nM - fm) < WGM ? (nM - fm) : WGM;
        u.pm = fm + ((wgid % nig) % gsz); u.pn = (wgid % nig) / gsz; return true;
    }
    __device__ __forceinline__ void a_ready(const Unit&) const {}
    __device__ __forceinline__ void done(const Unit&) const {}
};
typedef __bf16 bf16v2_t __attribute__((ext_vector_type(2)));
typedef float f32v2_t __attribute__((ext_vector_type(2)));
__device__ __forceinline__ unsigned cvt_pk_bf16(float lo, float hi) { const f32v2_t v = {lo, hi}; const bf16v2_t b = __builtin_convertvector(v, bf16v2_t); return __builtin_bit_cast(unsigned, b); }
template <class Epi, class Sched, bool STAMP = false>
__device__ __forceinline__ void gemm_phase(PG8_LAS unsigned char* lds, const Gemm g, const Sched& S, const Epi& E, unsigned long long* stamps) {
    const int tid = threadIdx.x, wid = __builtin_amdgcn_readfirstlane(tid >> 6), lane = tid & 63, wr = wid >> 2, wc = wid & 3, fr = lane & 15, fq = lane >> 4;
    const int K = g.K, nt = K / BK;
    int ts_lo = 0, ts_hi = 0, nts = 0; const unsigned long long rt_entry = STAMP ? (unsigned long long)wall_clock64() : 0ull;
#define PG8_STAMP() do { if (STAMP && wid == 0 && nts < 64) { const unsigned long long _c = (unsigned long long)clock64(); \
        ts_lo = (lane == nts) ? (int)(unsigned)_c : ts_lo; ts_hi = (lane == nts) ? (int)(unsigned)(_c >> 32) : ts_hi; ++nts; } } while (0)
    PG8_STAMP();
    unsigned voffA[2], voffB[2];
#pragma unroll
    for (int i = 0; i < 2; ++i) { int R, C; stage_rc(tid * 16 + i * 8192, R, C); const int Rb = Epi::PERM ? ((R & ~31) + perm32(R & 31)) : R;
        voffA[i] = (unsigned)(R * K + C) * 2u; voffB[i] = (unsigned)(Rb * K + C) * 2u; }
    const size_t kstep = (size_t)(BK * 2);
    const size_t hstep = (size_t)HALF * K * 2;
    const size_t tstep = 2 * hstep;
    const unsigned ldsw = (unsigned)wid * 1024u;
    const int aoff = lds_byte(wr * 64 + fr, fq * 8), boff = lds_byte(wc * 32 + fr, fq * 8);
#define PG8_SA(b, h) (((b) * 2 + (h)) * HTB)
#define PG8_SB(b, h) ((4 + (b) * 2 + (h)) * HTB)
#define PG8_STAGE(bufoff, gbase, voff) do { _Pragma("unroll") for (int _i = 0; _i < 2; ++_i) \
        __builtin_amdgcn_global_load_lds((const unsigned*)((const char*)(gbase) + (voff)[_i]), (PG8_LAS unsigned*)(lds + (bufoff) + ldsw + _i * 8192), 16, 0, 0); } while (0)
#define PG8_LDA(dst, b, h) do { _Pragma("unroll") for (int m = 0; m < 4; ++m) _Pragma("unroll") for (int k = 0; k < 2; ++k) dst[m][k] = *(const PG8_LAS bf16x8*)(lds + PG8_SA(b, h) + aoff + m * 2048 + k * 1024); } while (0)
#define PG8_LDB(dst, b, h) do { _Pragma("unroll") for (int n = 0; n < 2; ++n) _Pragma("unroll") for (int k = 0; k < 2; ++k) dst[n][k] = *(const PG8_LAS bf16x8*)(lds + PG8_SB(b, h) + boff + n * 2048 + k * 1024); } while (0)
#define PG8_MMA(ai, bj, At, Bt) do { __builtin_amdgcn_s_setprio(1); _Pragma("unroll") for (int m = 0; m < 4; ++m) _Pragma("unroll") for (int n = 0; n < 2; ++n) _Pragma("unroll") for (int k = 0; k < 2; ++k) \
        acc[ai][bj][m][n] = __builtin_amdgcn_mfma_f32_16x16x32_bf16(Bt[n][k], At[m][k], acc[ai][bj][m][n], 0, 0, 0); __builtin_amdgcn_s_setprio(0); } while (0)
#define PG8_WAIT_V(n) asm volatile("s_waitcnt vmcnt(" #n ")" ::: "memory")
#define PG8_WAIT_L(n) asm volatile("s_waitcnt lgkmcnt(" #n ")" ::: "memory")
#define PG8_BAR __builtin_amdgcn_s_barrier()
#define PG8_SCHED __builtin_amdgcn_sched_barrier(0)
    Unit cur, nxt; int ui = 0;
    if (!S.next(0, cur)) return;
    f32x4 acc[2][2][4][2];
#pragma unroll
    for (int a = 0; a < 2; ++a)
#pragma unroll
        for (int b = 0; b < 2; ++b)
#pragma unroll
            for (int m = 0; m < 4; ++m)
#pragma unroll
                for (int n = 0; n < 2; ++n) acc[a][b][m][n] = (f32x4){0.f, 0.f, 0.f, 0.f};
    bf16x8 At[4][2], B0[2][2], B1[2][2];
    const char* cA = (const char*)g.A + (size_t)cur.pm * tstep; const char* cB = (const char*)g.Bt + (size_t)cur.pn * tstep;
    S.a_ready(cur);
    PG8_STAGE(PG8_SB(0, 0), cB, voffB); PG8_STAGE(PG8_SA(0, 0), cA, voffA); PG8_STAGE(PG8_SB(0, 1), cB + hstep, voffB); PG8_STAGE(PG8_SA(0, 1), cA + hstep, voffA);
    if (wr == 1) PG8_BAR;
    PG8_WAIT_V(4); PG8_BAR;
    PG8_STAGE(PG8_SB(1, 0), cB + kstep, voffB); PG8_STAGE(PG8_SA(1, 0), cA + kstep, voffA); PG8_STAGE(PG8_SB(1, 1), cB + hstep + kstep, voffB);
    PG8_WAIT_V(6); PG8_BAR;
    PG8_STAMP();
    for (;;) {
        const bool has_next = S.next(ui + 1, nxt);
        const char* nA = has_next ? (const char*)g.A + (size_t)nxt.pm * tstep : cA; const char* nB = has_next ? (const char*)g.Bt + (size_t)nxt.pn * tstep : cB;
        for (int t = 0; t < nt; t += 2) {
            const bool last = (t == nt - 2);
            const char* a1 = cA + (size_t)(t + 1) * kstep;
            const char* a2 = last ? nA : cA + (size_t)(t + 2) * kstep; const char* b2 = last ? nB : cB + (size_t)(t + 2) * kstep;
            const char* a3 = a2 + kstep; const char* b3 = b2 + kstep;
            if (last && has_next) S.a_ready(nxt);
            PG8_LDB(B0, 0, 0); PG8_SCHED; PG8_LDA(At, 0, 0); PG8_STAGE(PG8_SA(1, 1), a1 + hstep, voffA);
            PG8_WAIT_L(8); PG8_BAR; PG8_WAIT_L(0); PG8_MMA(0, 0, At, B0); PG8_BAR; PG8_SCHED;
            PG8_LDB(B1, 0, 1); PG8_STAGE(PG8_SB(0, 0), b2, voffB);
            PG8_BAR; PG8_WAIT_L(0); PG8_MMA(0, 1, At, B1); PG8_BAR;
            PG8_LDA(At, 0, 1); PG8_STAGE(PG8_SA(0, 0), a2, voffA);
            PG8_BAR; PG8_WAIT_L(0); PG8_MMA(1, 0, At, B0); PG8_BAR; PG8_SCHED;
            PG8_STAGE(PG8_SB(0, 1), b2 + hstep, voffB);
            PG8_WAIT_V(6); PG8_BAR; PG8_MMA(1, 1, At, B1); PG8_BAR;
            PG8_LDB(B0, 1, 0); PG8_SCHED; PG8_LDA(At, 1, 0); PG8_STAGE(PG8_SA(0, 1), a2 + hstep, voffA);
            PG8_WAIT_L(8); PG8_BAR; PG8_WAIT_L(0); PG8_MMA(0, 0, At, B0); PG8_BAR; PG8_SCHED;
            PG8_LDB(B1, 1, 1); PG8_STAGE(PG8_SB(1, 0), b3, voffB);
            PG8_BAR; PG8_WAIT_L(0); PG8_MMA(0, 1, At, B1); PG8_BAR;
            PG8_LDA(At, 1, 1); PG8_STAGE(PG8_SA(1, 0), a3, voffA);
            PG8_BAR; PG8_WAIT_L(0); PG8_MMA(1, 0, At, B0); PG8_BAR; PG8_SCHED;
            PG8_STAGE(PG8_SB(1, 1), b3 + hstep, voffB);
            PG8_WAIT_V(6); PG8_BAR; PG8_MMA(1, 1, At, B1); PG8_BAR;
        }
        PG8_STAMP();
        if constexpr (!Epi::AFTER_DRAIN) { E(acc, cur, wr, wc, fr, fq); S.done(cur); }
        PG8_STAMP();
        if (!has_next) break;
#pragma unroll
        for (int a = 0; a < 2; ++a)
#pragma unroll
            for (int b = 0; b < 2; ++b)
#pragma unroll
                for (int m = 0; m < 4; ++m)
#pragma unroll
                    for (int n = 0; n < 2; ++n) acc[a][b][m][n] = (f32x4){0.f, 0.f, 0.f, 0.f};
        cur = nxt; cA = nA; cB = nB; ++ui;
    }
    PG8_WAIT_V(0);
    if (wr == 0) PG8_BAR;
    PG8_BAR;
    if constexpr (Epi::AFTER_DRAIN) { E.fused(acc, cur, wr, wc, fr, fq, lds, wid, lane); S.done(cur); }
    PG8_STAMP();
    if (STAMP && wid == 0) { stamps[lane] = lane < nts ? (((unsigned long long)(unsigned)ts_hi << 32) | (unsigned)ts_lo) : 0ull;
        if (lane == 62) stamps[62] = rt_entry; if (lane == 63) stamps[63] = (unsigned long long)wall_clock64(); }
#undef PG8_STAMP
#undef PG8_SA
#undef PG8_SB
#undef PG8_STAGE
#undef PG8_LDA
#undef PG8_LDB
#undef PG8_MMA
#undef PG8_WAIT_V
#undef PG8_WAIT_L
#undef PG8_BAR
#undef PG8_SCHED
}
}

using pg8::bf16_t; using pg8::bf16x8; using pg8::f32x4; using pg8::u32x4; using pg8::Unit; using pg8::cvt_pk_bf16;
#define LAS __attribute__((address_space(3)))
typedef float f32x2 __attribute__((ext_vector_type(2)));
typedef unsigned u32x2 __attribute__((ext_vector_type(2)));
typedef _Float16 f16x2 __attribute__((ext_vector_type(2)));
typedef _Float16 f16x8 __attribute__((ext_vector_type(8)));

constexpr int D = 1024, ML = 16384, MC = 512, MT = ML + MC, DFF = 2816, DH = 768, DIN = 4096, NMODD = 9 * 1024;
constexpr float EPS = 1e-6f;
constexpr int NTHR = 512;
constexpr int LDS_BYTES = 147456;

constexpr size_t al256(size_t x) { return (x + 255) & ~(size_t)255; }
constexpr size_t WS_MOD   = 4096;
constexpr size_t WS_XC    = al256(WS_MOD + (size_t)2 * 3 * NMODD * 4);
constexpr size_t SZ_UP    = (size_t)2 * DFF * D * 2;
constexpr size_t SZ_DN    = (size_t)D * DFF * 2;
constexpr size_t WS_UP0   = al256(WS_XC + (size_t)MC * D * 4);
constexpr size_t WS_DN0   = WS_UP0 + 2 * SZ_UP;
constexpr size_t WS_WIN   = WS_DN0 + 2 * SZ_DN;
constexpr size_t WS_WOUT  = WS_WIN + (size_t)DIN * D * 2;
constexpr size_t WS_GIN   = WS_WOUT + (size_t)D * D * 2;
constexpr size_t WS_GOUT  = WS_GIN + (size_t)2 * D * D * 2;
constexpr size_t WS_WS    = WS_GOUT + (size_t)D * D * 2;
constexpr size_t WS_H     = al256(WS_WS + (size_t)8 * 128 * 128 * 2);
constexpr size_t WS_R     = al256(WS_H + (size_t)MT * D * 2);
constexpr size_t R_G      = 0;
constexpr size_t R_UP1    = al256((size_t)MT * DFF * 2 + 4096);
constexpr size_t R_DN1    = R_UP1 + 2 * SZ_UP;
constexpr size_t R_FFN_END = R_DN1 + 2 * SZ_DN;
constexpr size_t R_PP     = 0;
constexpr size_t R_Q      = al256(R_PP + (size_t)MT * 256 * 4);
constexpr size_t R_V      = al256(R_Q + (size_t)MT * DH * 2);
constexpr size_t R_GT     = al256(R_V + (size_t)MT * DH * 2);
constexpr size_t R_LF     = al256(R_GT + (size_t)MT * DH * 2);
constexpr size_t R_DS     = al256(R_LF + (size_t)2 * MT * DH * 2);
constexpr size_t R_DEC    = al256(R_DS + (size_t)1536 * 16384 * 2);
constexpr size_t R_AB_END = al256(R_DEC + (size_t)1536 * 128 * 4);
constexpr size_t R_U      = 0;
constexpr size_t R_VG     = (size_t)ML * D * 2;
constexpr size_t R_SIZE   = R_AB_END > R_FFN_END ? R_AB_END : R_FFN_END;
constexpr size_t WS_END   = WS_R + R_SIZE;

struct Args {
    const float* in[23]; float* out; unsigned char* ws; int ph_lo, ph_hi;
};

struct Frame {
    LAS unsigned char* lds; int tid, lane, wid, G, bid;
    float* out; unsigned char* ws;
};

__device__ __forceinline__ float bf_lo(unsigned w) { return __uint_as_float(w << 16); }
__device__ __forceinline__ float bf_hi(unsigned w) { return __uint_as_float(w & 0xffff0000u); }
__device__ __forceinline__ float fast_rcp(float x) { return __builtin_amdgcn_rcpf(x); }
__device__ __forceinline__ float sigmoidf_(float x) { return fast_rcp(1.0f + __expf(-x)); }
__device__ __forceinline__ float siluf_(float x) { return x * sigmoidf_(x); }
__device__ __forceinline__ float gelu_tanh(float x) { const float u = 0.7978845608f * (x + 0.044715f * x * x * x); return x * sigmoidf_(2.0f * u); }
__device__ __forceinline__ f32x4 mfma16(bf16x8 a, bf16x8 b, f32x4 c) { return __builtin_amdgcn_mfma_f32_16x16x32_bf16(a, b, c, 0, 0, 0); }

struct EpiSwiGlu {
    static constexpr bool PERM = true, AFTER_DRAIN = false;
    bf16_t* G;
    __device__ __forceinline__ void operator()(const f32x4 (&acc)[2][2][4][2], const Unit& u, int wr, int wc, int fr, int fq) const {
        const int row0 = u.pm * 256 + wr * 64 + fr, col0 = u.pn * 128 + wc * 32 + 8 * fq;
#pragma unroll
        for (int ai = 0; ai < 2; ++ai)
#pragma unroll
            for (int m = 0; m < 4; ++m) {
                bf16_t* p = G + (size_t)(row0 + ai * 128 + m * 16) * DFF + col0;
                const f32x4 a0 = acc[ai][0][m][0], a1 = acc[ai][0][m][1], b0 = acc[ai][1][m][0], b1 = acc[ai][1][m][1];
                u32x4 w;
                w.x = cvt_pk_bf16(siluf_(a0[0]) * b0[0], siluf_(a0[1]) * b0[1]); w.y = cvt_pk_bf16(siluf_(a0[2]) * b0[2], siluf_(a0[3]) * b0[3]);
                w.z = cvt_pk_bf16(siluf_(a1[0]) * b1[0], siluf_(a1[1]) * b1[1]); w.w = cvt_pk_bf16(siluf_(a1[2]) * b1[2], siluf_(a1[3]) * b1[3]);
                *(u32x4*)p = w;
            }
    }
};
struct EpiResid {
    static constexpr bool PERM = false, AFTER_DRAIN = false;
    const float* baseL; const float* baseC; float* outL; float* outC; const float* gate  ; float scale;
    __device__ __forceinline__ void operator()(const f32x4 (&acc)[2][2][4][2], const Unit& u, int wr, int wc, int fr, int fq) const {
        const bool isc = u.pm >= 64; const int vec = isc ? 2 : (u.pm >> 5);
        const int row0 = (isc ? (u.pm - 64) * 256 : u.pm * 256) + wr * 64 + fr, col0 = u.pn * 256 + wc * 32 + 4 * fq;
        const float* base = isc ? baseC : baseL; float* out = isc ? outC : outL;
#pragma unroll
        for (int bj = 0; bj < 2; ++bj)
#pragma unroll
            for (int n = 0; n < 2; ++n) {
                const f32x4 gv = *(const f32x4*)(gate + (size_t)vec * NMODD + col0 + bj * 128 + n * 16) * scale;
#pragma unroll
                for (int ai = 0; ai < 2; ++ai)
#pragma unroll
                    for (int m = 0; m < 4; ++m) { const size_t off = (size_t)(row0 + ai * 128 + m * 16) * D + col0 + bj * 128 + n * 16;
                        const f32x4 b = *(const f32x4*)(base + off); *(f32x4*)(out + off) = b + gv * acc[ai][bj][m][n]; }
                __builtin_amdgcn_sched_barrier(0);
            }
    }
};
struct EpiWin {
    static constexpr bool PERM = true, AFTER_DRAIN = false;
    unsigned char* R  ; const float* lb  ;
    __device__ __forceinline__ void operator()(const f32x4 (&acc)[2][2][4][2], const Unit& u, int wr, int wc, int fr, int fq) const {
        const int row0 = u.pm * 256 + wr * 64 + fr, cw = wc * 32 + 8 * fq;
        const int pn = u.pn;
        if (pn == 0) {
#pragma unroll
            for (int ai = 0; ai < 2; ++ai)
#pragma unroll
                for (int m = 0; m < 4; ++m) { float* p = (float*)(R + R_PP) + (size_t)(row0 + ai * 128 + m * 16) * 256 + cw;
#pragma unroll
                    for (int bj = 0; bj < 2; ++bj) { *(f32x4*)(p + bj * 128) = acc[ai][bj][m][0]; *(f32x4*)(p + bj * 128 + 4) = acc[ai][bj][m][1]; } }
            return;
        }
        const int sec = (pn - 1) / 3, scol = ((pn - 1) % 3) * 256 + cw;
        if (sec == 2 || sec == 3) {
            const int dir = sec - 2; _Float16* O = (_Float16*)(R + R_LF) + (size_t)dir * MT * DH;
#pragma unroll
            for (int bj = 0; bj < 2; ++bj) {
                float lbv[8];
#pragma unroll
                for (int e = 0; e < 8; ++e) { const int c = scol + bj * 128 + e; const float l0 = lb[dir * DH + c], l1 = lb[2 * DH + dir * DH + c]; lbv[e] = fast_rcp(1.0f + __expf(l1 - l0)); }
#pragma unroll
                for (int ai = 0; ai < 2; ++ai)
#pragma unroll
                    for (int m = 0; m < 4; ++m) { _Float16* p = O + (size_t)(row0 + ai * 128 + m * 16) * DH + scol; f16x8 w;
#pragma unroll
                        for (int e = 0; e < 8; ++e) { const float a = acc[ai][bj][m][e >> 2][e & 3]; const float l = lbv[e]; const float fg = l + (1.0f - l) * sigmoidf_(a); w[e] = (_Float16)__logf(fg); }
                        *(f16x8*)(p + bj * 128) = w; }
                __builtin_amdgcn_sched_barrier(0);
            }
            return;
        }
        const size_t ooff = sec == 0 ? R_Q : (sec == 1 ? R_V : R_GT); bf16_t* O = (bf16_t*)(R + ooff);
#pragma unroll
        for (int ai = 0; ai < 2; ++ai)
#pragma unroll
            for (int m = 0; m < 4; ++m) { bf16_t* p = O + (size_t)(row0 + ai * 128 + m * 16) * DH + scol;
#pragma unroll
                for (int bj = 0; bj < 2; ++bj) { float v[8];
#pragma unroll
                    for (int e = 0; e < 8; ++e) { const float a = acc[ai][bj][m][e >> 2][e & 3]; v[e] = sec == 0 ? siluf_(a) * 0.08838834764831845f : (sec == 1 ? a : siluf_(a)); }
                    u32x4 w; w.x = cvt_pk_bf16(v[0], v[1]); w.y = cvt_pk_bf16(v[2], v[3]); w.z = cvt_pk_bf16(v[4], v[5]); w.w = cvt_pk_bf16(v[6], v[7]);
                    *(u32x4*)(p + bj * 128) = w; } }
    }
};
struct EpiGin {
    static constexpr bool PERM = true, AFTER_DRAIN = false;
    bf16_t* U; bf16_t* VG;
    __device__ __forceinline__ void operator()(const f32x4 (&acc)[2][2][4][2], const Unit& u, int wr, int wc, int fr, int fq) const {
        const int row0 = u.pm * 256 + wr * 64 + fr; bf16_t* O = u.pn < 4 ? U : VG; const int col0 = (u.pn & 3) * 256 + wc * 32 + 8 * fq;
#pragma unroll
        for (int ai = 0; ai < 2; ++ai)
#pragma unroll
            for (int m = 0; m < 4; ++m) { bf16_t* p = O + (size_t)(row0 + ai * 128 + m * 16) * D + col0;
#pragma unroll
                for (int bj = 0; bj < 2; ++bj) { const f32x4 a0 = acc[ai][bj][m][0], a1 = acc[ai][bj][m][1]; u32x4 w;
                    w.x = cvt_pk_bf16(gelu_tanh(a0[0]), gelu_tanh(a0[1])); w.y = cvt_pk_bf16(gelu_tanh(a0[2]), gelu_tanh(a0[3]));
                    w.z = cvt_pk_bf16(gelu_tanh(a1[0]), gelu_tanh(a1[1])); w.w = cvt_pk_bf16(gelu_tanh(a1[2]), gelu_tanh(a1[3]));
                    *(u32x4*)(p + bj * 128) = w; } }
    }
};

template <class Epi>
__device__ __forceinline__ void run_gemm(const Frame& F, const bf16_t* A, const bf16_t* Bt, int M, int N, int K, const Epi& E) {
    pg8::StaticOrder S; S.init(M, N, F.G, F.bid);
    pg8::Gemm g; g.A = A; g.Bt = Bt; g.M = M; g.N = N; g.K = K;
    pg8::gemm_phase<Epi, pg8::StaticOrder, false>(F.lds, g, S, E, nullptr);
    __syncthreads();
}

__device__ __forceinline__ void transpose_tile(const Frame& F, const float* W, bf16_t* Bt, int K, int N, int mode, int tile) {
    LAS float* T = (LAS float*)F.lds;
    const int ntn = N >> 6, tk = tile / ntn, tn = tile % ntn, k0 = tk * 64, n0 = tn * 64;
    const int tid = F.tid;
    __syncthreads();
#pragma unroll
    for (int i = 0; i < 8; ++i) { const int r = (tid >> 6) + 8 * i, c = tid & 63; T[r * 65 + c] = W[(size_t)(k0 + r) * N + n0 + c]; }
    __syncthreads();
    const int nl = tid >> 3, k8 = (tid & 7) * 8;
    const float v0 = T[(k8 + 0) * 65 + nl], v1 = T[(k8 + 1) * 65 + nl], v2 = T[(k8 + 2) * 65 + nl], v3 = T[(k8 + 3) * 65 + nl], v4 = T[(k8 + 4) * 65 + nl], v5 = T[(k8 + 5) * 65 + nl], v6 = T[(k8 + 6) * 65 + nl], v7 = T[(k8 + 7) * 65 + nl];
    const int n = n0 + nl; const int row = mode == 0 ? n : ((n >> 7) * 256 + (n & 127) + (mode == 2 ? 128 : 0));
    u32x4 w; w.x = cvt_pk_bf16(v0, v1); w.y = cvt_pk_bf16(v2, v3); w.z = cvt_pk_bf16(v4, v5); w.w = cvt_pk_bf16(v6, v7);
    *(u32x4*)(Bt + (size_t)row * K + k0 + k8) = w;
}
__device__ __forceinline__ void do_tjob(const Frame& F, const Args& A, int set, int i, int tile) {
    const int layer = set;
    unsigned char* upb = set == 0 ? F.ws + WS_UP0 : F.ws + WS_R + R_UP1; unsigned char* dnb = set == 0 ? F.ws + WS_DN0 : F.ws + WS_R + R_DN1;
    const float* W; bf16_t* Bt; int K, N, mode;
    if (i < 4) { const int f = i >> 1, which = i & 1; W = (which ? A.in[8] : A.in[7]) + (size_t)(layer * 2 + f) * D * DFF; Bt = (bf16_t*)(upb + (size_t)f * SZ_UP); K = D; N = DFF; mode = 1 + which; }
    else if (i < 6) { const int f = i - 4; W = A.in[9] + (size_t)(layer * 2 + f) * DFF * D; Bt = (bf16_t*)(dnb + (size_t)f * SZ_DN); K = DFF; N = D; mode = 0; }
    else if (i == 6) { W = A.in[10]; Bt = (bf16_t*)(F.ws + WS_WIN); K = D; N = DIN; mode = 0; }
    else if (i == 7) { W = A.in[15]; Bt = (bf16_t*)(F.ws + WS_WOUT); K = D; N = D; mode = 0; }
    else if (i == 8) { W = A.in[16]; Bt = (bf16_t*)(F.ws + WS_GIN); K = D; N = 2 * D; mode = 0; }
    else { W = A.in[21]; Bt = (bf16_t*)(F.ws + WS_GOUT); K = D; N = D; mode = 0; }
    transpose_tile(F, W, Bt, K, N, mode, tile);
}
__device__ __forceinline__ int tjob_tiles(int i) { return i < 6 ? 704 : (i == 6 ? 1024 : (i == 8 ? 512 : 256)); }
__device__ __forceinline__ void run_tjobs(const Frame& F, const Args& A, int set) {
    const int nj = set == 0 ? 10 : 6;
    int total = 0;
    for (int i = 0; i < nj; ++i) total += tjob_tiles(i);
    for (int t = F.bid; t < total; t += F.G) {
        int rem = t, ji = 0;
        for (int i = 0; i < nj; ++i) { const int c = tjob_tiles(i); if (rem < c) { ji = i; break; } rem -= c; }
        do_tjob(F, A, set, ji, rem);
    }
    __syncthreads();
}

__device__ __forceinline__ void mod_phase(const Frame& F, const float* c_in, const float* c_ctx, const float* mod_w, const float* mod_b, const float* w_s) {
    LAS float* SC = (LAS float*)F.lds;
    LAS float* RED = (LAS float*)(F.lds + 3 * 1024 * 4);
    const int tid = F.tid;
    __syncthreads();
    for (int i = tid; i < 3 * 1024; i += NTHR) { const int v = i >> 10, k = i & 1023; const float c = v < 2 ? c_in[v * 1024 + k] : c_ctx[k]; SC[i] = siluf_(c); }
    __syncthreads();
    float* MOD = (float*)(F.ws + WS_MOD);
    const int cg4 = tid & 15, ks = tid >> 4;
    for (int item = F.bid; item < 2 * 144; item += F.G) {
        const int l = item / 144, n0 = (item % 144) * 64;
        const float* W = mod_w + (size_t)l * D * NMODD + n0 + cg4 * 4;
        f32x4 a0 = {0.f, 0.f, 0.f, 0.f}, a1 = a0, a2 = a0;
#pragma unroll 8
        for (int r = 0; r < 32; ++r) { const int k = ks * 32 + r; const f32x4 w = *(const f32x4*)(W + (size_t)k * NMODD); a0 += w * SC[k]; a1 += w * SC[1024 + k]; a2 += w * SC[2048 + k]; }
        __syncthreads();
        *(LAS f32x4*)(RED + (ks * 3 + 0) * 64 + cg4 * 4) = a0; *(LAS f32x4*)(RED + (ks * 3 + 1) * 64 + cg4 * 4) = a1; *(LAS f32x4*)(RED + (ks * 3 + 2) * 64 + cg4 * 4) = a2;
        __syncthreads();
        if (tid < 192) { const int v = tid >> 6, c = tid & 63; float s = 0.f;
            for (int k2 = 0; k2 < 32; ++k2) s += RED[(k2 * 3 + v) * 64 + c];
            MOD[(size_t)(l * 3 + v) * NMODD + n0 + c] = s + mod_b[(size_t)l * NMODD + n0 + c]; }
    }
    __syncthreads();
    bf16_t* WSB = (bf16_t*)(F.ws + WS_WS);
    for (int i = (F.bid * NTHR + tid) * 2; i < 8 * 128 * 128; i += F.G * NTHR * 2) { const f32x2 v = *(const f32x2*)(w_s + i); *(unsigned*)(WSB + i) = cvt_pk_bf16(v.x, v.y); }
}

__device__ __forceinline__ void norm_phase(const Frame& F, const float* xl, const float* xc, int nrows, const float* g, const float* modl, int s, bf16_t* H) {
    const int lane = F.lane;
    for (int row = F.bid * 8 + F.wid; row < nrows; row += F.G * 8) {
        const float* src = row < ML ? xl + (size_t)row * D : xc + (size_t)(row - ML) * D; const int vec = row < 8192 ? 0 : (row < ML ? 1 : 2);
        f32x4 v[4]; float ss = 0.f;
#pragma unroll
        for (int i = 0; i < 4; ++i) { v[i] = *(const f32x4*)(src + i * 256 + lane * 4); ss += v[i][0] * v[i][0] + v[i][1] * v[i][1] + v[i][2] * v[i][2] + v[i][3] * v[i][3]; }
#pragma unroll
        for (int o = 32; o >= 1; o >>= 1) ss += __shfl_xor(ss, o);
        const float rstd = 1.0f / sqrtf(ss * (1.0f / D) + EPS);
        const float* sc = modl + (size_t)vec * NMODD + (3 * s + 1) * 1024; const float* sh = modl + (size_t)vec * NMODD + (3 * s) * 1024;
#pragma unroll
        for (int i = 0; i < 4; ++i) { const int c = i * 256 + lane * 4; const f32x4 gg = *(const f32x4*)(g + c), s4 = *(const f32x4*)(sc + c), h4 = *(const f32x4*)(sh + c);
            const f32x4 y = (v[i] * rstd) * gg * (s4 + 1.0f) + h4; u32x2 w; w.x = cvt_pk_bf16(y[0], y[1]); w.y = cvt_pk_bf16(y[2], y[3]); *(u32x2*)(H + (size_t)row * D + c) = w; }
    }
}
__device__ __forceinline__ void final_norm_phase(const Frame& F, float* x, const float* g) {
    const int lane = F.lane;
    for (int row = F.bid * 8 + F.wid; row < ML; row += F.G * 8) {
        float* src = x + (size_t)row * D; f32x4 v[4]; float ss = 0.f;
#pragma unroll
        for (int i = 0; i < 4; ++i) { v[i] = *(const f32x4*)(src + i * 256 + lane * 4); ss += v[i][0] * v[i][0] + v[i][1] * v[i][1] + v[i][2] * v[i][2] + v[i][3] * v[i][3]; }
#pragma unroll
        for (int o = 32; o >= 1; o >>= 1) ss += __shfl_xor(ss, o);
        const float rstd = 1.0f / sqrtf(ss * (1.0f / D) + EPS);
#pragma unroll
        for (int i = 0; i < 4; ++i) { const int c = i * 256 + lane * 4; *(f32x4*)(src + c) = (v[i] * rstd) * *(const f32x4*)(g + c); }
    }
}

constexpr int RS128 = 136, RS64 = 72;
constexpr int QE_OFF = 0, KE_OFF = 17408, QD_OFF = 34816, KDT_OFF = 52224, VT_OFF = 70656, AL_OFF = 89088, ST_OFF = 98304, TOT_OFF = 133120, BL_OFF = 137216, RED_OFF = 137728;

template <bool OUT>
__device__ __forceinline__ void scan_chunk(const Frame& F, const bf16_t* Qg, const bf16_t* Vg, const _Float16* LFg, int row0, int hcol, bool rev, f32x4 (&Sacc)[8], f32x4 (&oacc)[4], float& ld0, float& ld1) {
    LAS unsigned char* lds = F.lds; const int wid = F.wid, lane = F.lane, r = lane & 15, q = lane >> 4;
    LAS float* TOT = (LAS float*)(lds + TOT_OFF); LAS float* BL = (LAS float*)(lds + BL_OFF);
    const int c0 = hcol + 2 * lane;
    float c_0[8], c_1[8], lf0[8], lf1[8]; unsigned qv[8], vv[8];
#pragma unroll
    for (int i = 0; i < 8; ++i) { const size_t ro = (size_t)(row0 + 8 * wid + i) * DH + c0; const f16x2 h = *(const f16x2*)(LFg + ro); lf0[i] = (float)h.x; lf1[i] = (float)h.y;
        vv[i] = *(const unsigned*)(Vg + ro); if (OUT) qv[i] = *(const unsigned*)(Qg + ro); else qv[i] = 0u; }
    float t0 = 0.f, t1 = 0.f;
    if (!rev) {
#pragma unroll
        for (int i = 0; i < 8; ++i) { t0 += lf0[i]; t1 += lf1[i]; c_0[i] = t0; c_1[i] = t1; }
    } else {
#pragma unroll
        for (int i = 7; i >= 0; --i) { t0 += lf0[i]; t1 += lf1[i]; c_0[i] = t0; c_1[i] = t1; }
    }
    *(LAS f32x2*)(TOT + wid * 128 + 2 * lane) = (f32x2){t0, t1};
    __syncthreads();
    __builtin_amdgcn_sched_barrier(0);
    float off0 = 0.f, off1 = 0.f, mid0 = 0.f, mid1 = 0.f, last0 = 0.f, last1 = 0.f;
#pragma unroll
    for (int w = 0; w < 8; ++w) { const f32x2 t = *(LAS f32x2*)(TOT + w * 128 + 2 * lane); last0 += t.x; last1 += t.y;
        const bool before = rev ? (w > wid) : (w < wid); if (before) { off0 += t.x; off1 += t.y; }
        const bool inmid = rev ? (w >= 4) : (w < 4); if (inmid) { mid0 += t.x; mid1 += t.y; } }
    if (wid == 0) *(LAS f32x2*)(BL + 2 * lane) = (f32x2){last0, last1};
    ld0 += last0; ld1 += last1;
    unsigned kd0p[4], kd1p[4];
    {
        float kd0[8], kd1[8];
#pragma unroll
        for (int i = 0; i < 8; ++i) {
            const float b0 = off0 + c_0[i], b1 = off1 + c_1[i];
            const float k0 = 1.0f - __expf(lf0[i]), k1 = 1.0f - __expf(lf1[i]);
            kd0[i] = k0 * __expf(last0 - b0); kd1[i] = k1 * __expf(last1 - b1);
            if (OUT) {
                const float q0 = bf_lo(qv[i]), q1 = bf_hi(qv[i]); const int j = 8 * wid + i;
                *(LAS unsigned*)(lds + QE_OFF + (j * RS128 + 2 * lane) * 2) = cvt_pk_bf16(q0 * __expf(b0 - mid0), q1 * __expf(b1 - mid1));
                *(LAS unsigned*)(lds + KE_OFF + (j * RS128 + 2 * lane) * 2) = cvt_pk_bf16(k0 * __expf(mid0 - b0), k1 * __expf(mid1 - b1));
                *(LAS unsigned*)(lds + QD_OFF + (j * RS128 + 2 * lane) * 2) = cvt_pk_bf16(q0 * __expf(b0), q1 * __expf(b1));
            }
        }
#pragma unroll
        for (int k = 0; k < 4; ++k) { kd0p[k] = cvt_pk_bf16(kd0[2 * k], kd0[2 * k + 1]); kd1p[k] = cvt_pk_bf16(kd1[2 * k], kd1[2 * k + 1]); }
    }
    *(LAS u32x4*)(lds + KDT_OFF + ((2 * lane) * RS64 + 8 * wid) * 2) = (u32x4){kd0p[0], kd0p[1], kd0p[2], kd0p[3]};
    *(LAS u32x4*)(lds + KDT_OFF + ((2 * lane + 1) * RS64 + 8 * wid) * 2) = (u32x4){kd1p[0], kd1p[1], kd1p[2], kd1p[3]};
    {
        u32x4 a, b;
        a.x = (vv[0] & 0xffffu) | (vv[1] << 16); a.y = (vv[2] & 0xffffu) | (vv[3] << 16); a.z = (vv[4] & 0xffffu) | (vv[5] << 16); a.w = (vv[6] & 0xffffu) | (vv[7] << 16);
        b.x = (vv[0] >> 16) | (vv[1] & 0xffff0000u); b.y = (vv[2] >> 16) | (vv[3] & 0xffff0000u); b.z = (vv[4] >> 16) | (vv[5] & 0xffff0000u); b.w = (vv[6] >> 16) | (vv[7] & 0xffff0000u);
        *(LAS u32x4*)(lds + VT_OFF + ((2 * lane) * RS64 + 8 * wid) * 2) = a;
        *(LAS u32x4*)(lds + VT_OFF + ((2 * lane + 1) * RS64 + 8 * wid) * 2) = b;
    }
    __syncthreads();
    __builtin_amdgcn_sched_barrier(0);
    if (OUT) {
        const int jt = wid >> 1;
#pragma unroll
        for (int x = 0; x < 2; ++x) {
            const int it = (wid & 1) * 2 + x; f32x4 a = {0.f, 0.f, 0.f, 0.f};
            const bool dead = rev ? (it < jt) : (it > jt);
            if (!dead) {
#pragma unroll
                for (int kt = 0; kt < 4; ++kt) { const bf16x8 P = *(const LAS bf16x8*)(lds + KE_OFF + ((it * 16 + r) * RS128 + kt * 32 + 8 * q) * 2), Qf = *(const LAS bf16x8*)(lds + QE_OFF + ((jt * 16 + r) * RS128 + kt * 32 + 8 * q) * 2);
                    a = mfma16(P, Qf, a); }
            }
            const int j = jt * 16 + r;
#pragma unroll
            for (int e = 0; e < 4; ++e) { const int i = it * 16 + 4 * q + e; const bool keep = rev ? (i >= j) : (i <= j); if (!keep) a[e] = 0.f; }
            *(LAS u32x2*)(lds + AL_OFF + (j * RS64 + it * 16 + 4 * q) * 2) = (u32x2){cvt_pk_bf16(a[0], a[1]), cvt_pk_bf16(a[2], a[3])};
            __builtin_amdgcn_sched_barrier(0);
        }
        __syncthreads();
#pragma unroll
        for (int jt2 = 0; jt2 < 4; ++jt2) {
            f32x4 o = oacc[jt2];
#pragma unroll
            for (int kt = 0; kt < 4; ++kt) { const bf16x8 P = *(const LAS bf16x8*)(lds + ST_OFF + ((16 * wid + r) * RS128 + kt * 32 + 8 * q) * 2), Qf = *(const LAS bf16x8*)(lds + QD_OFF + ((jt2 * 16 + r) * RS128 + kt * 32 + 8 * q) * 2);
                o = mfma16(P, Qf, o); }
#pragma unroll
            for (int kt = 0; kt < 2; ++kt) { const bf16x8 P = *(const LAS bf16x8*)(lds + VT_OFF + ((16 * wid + r) * RS64 + kt * 32 + 8 * q) * 2), Qf = *(const LAS bf16x8*)(lds + AL_OFF + ((jt2 * 16 + r) * RS64 + kt * 32 + 8 * q) * 2);
                o = mfma16(P, Qf, o); }
            oacc[jt2] = o;
            __builtin_amdgcn_sched_barrier(0);
        }
    }
#pragma unroll
    for (int dt = 0; dt < 8; ++dt) {
        const f32x4 bl = *(const LAS f32x4*)(BL + 16 * dt + 4 * q);
        f32x4 s = Sacc[dt]; s[0] *= __expf(bl[0]); s[1] *= __expf(bl[1]); s[2] *= __expf(bl[2]); s[3] *= __expf(bl[3]);
#pragma unroll
        for (int kt = 0; kt < 2; ++kt) { const bf16x8 P = *(const LAS bf16x8*)(lds + KDT_OFF + ((16 * dt + r) * RS64 + kt * 32 + 8 * q) * 2), Qf = *(const LAS bf16x8*)(lds + VT_OFF + ((16 * wid + r) * RS64 + kt * 32 + 8 * q) * 2);
            s = mfma16(P, Qf, s); }
        Sacc[dt] = s;
        if (OUT) *(LAS u32x2*)(lds + ST_OFF + ((16 * wid + r) * RS128 + 16 * dt + 4 * q) * 2) = (u32x2){cvt_pk_bf16(s[0], s[1]), cvt_pk_bf16(s[2], s[3])};
        __builtin_amdgcn_sched_barrier(0);
    }
}

__device__ __forceinline__ void scan_pass1(const Frame& F) {
    const bf16_t* Vg = (const bf16_t*)(F.ws + WS_R + R_V); const _Float16* LF = (const _Float16*)(F.ws + WS_R + R_LF);
    bf16_t* DS = (bf16_t*)(F.ws + WS_R + R_DS); float* DEC = (float*)(F.ws + WS_R + R_DEC);
    const int wid = F.wid, lane = F.lane, r = lane & 15, q = lane >> 4;
#pragma unroll 1
    for (int item = F.bid; item < 24 * 64; item += F.G) {
        const int chain = item >> 6, n = item & 63, dir = chain & 1, bh = chain >> 1, b = bh / 6, h = bh % 6;
        const _Float16* LFg = LF + (size_t)dir * MT * DH;
        int rowbase, nch;
        if (n == 0) { rowbase = ML + b * 256; nch = 4; } else { const int sc = n - 1, mphys = dir ? 63 - sc : sc; rowbase = b * 8192 + mphys * 128; nch = 2; }
        f32x4 Sacc[8], odum[4];
#pragma unroll
        for (int i = 0; i < 8; ++i) Sacc[i] = (f32x4){0.f, 0.f, 0.f, 0.f};
        float ld0 = 0.f, ld1 = 0.f;
#pragma unroll 1
        for (int cc = 0; cc < nch; ++cc) { const int c = dir ? nch - 1 - cc : cc; scan_chunk<false>(F, nullptr, Vg, LFg, rowbase + 64 * c, h * 128, dir != 0, Sacc, odum, ld0, ld1); }
        bf16_t* slot = DS + (size_t)item * 16384;
#pragma unroll
        for (int dt = 0; dt < 8; ++dt) *(u32x2*)(slot + (16 * wid + r) * 128 + 16 * dt + 4 * q) = (u32x2){cvt_pk_bf16(Sacc[dt][0], Sacc[dt][1]), cvt_pk_bf16(Sacc[dt][2], Sacc[dt][3])};
        if (wid == 0) *(f32x2*)(DEC + (size_t)item * 128 + 2 * lane) = (f32x2){__expf(ld0), __expf(ld1)};
    }
    __syncthreads();
}
__device__ __forceinline__ void scan_pass2(const Frame& F) {
    bf16_t* DS = (bf16_t*)(F.ws + WS_R + R_DS); const float* DEC = (const float*)(F.ws + WS_R + R_DEC);
    for (int idx = F.bid * NTHR + F.tid; idx < 24 * 8192; idx += F.G * NTHR) {
        const int chain = idx >> 13, e2 = (idx & 8191) * 2, d = e2 & 127;
        bf16_t* p = DS + (size_t)chain * 64 * 16384 + e2; const float* dc = DEC + (size_t)chain * 64 * 128 + d;
        unsigned w = *(const unsigned*)p; float t0 = bf_lo(w), t1 = bf_hi(w);
#pragma unroll 4
        for (int m = 1; m < 64; ++m) { const unsigned x = *(const unsigned*)(p + (size_t)m * 16384); const f32x2 de = *(const f32x2*)(dc + m * 128);
            t0 = de.x * t0 + bf_lo(x); t1 = de.y * t1 + bf_hi(x); *(unsigned*)(p + (size_t)m * 16384) = cvt_pk_bf16(t0, t1); }
    }
}
__device__ __forceinline__ void scan_pass3(const Frame& F, const float* hgrn_norm_g) {
    const bf16_t* Qg = (const bf16_t*)(F.ws + WS_R + R_Q); const bf16_t* Vg = (const bf16_t*)(F.ws + WS_R + R_V); const bf16_t* GT = (const bf16_t*)(F.ws + WS_R + R_GT);
    const _Float16* LF = (const _Float16*)(F.ws + WS_R + R_LF); const bf16_t* DS = (const bf16_t*)(F.ws + WS_R + R_DS); bf16_t* HM = (bf16_t*)(F.ws + WS_H);
    LAS unsigned char* lds = F.lds; LAS float* RED = (LAS float*)(lds + RED_OFF);
    const int wid = F.wid, lane = F.lane, r = lane & 15, q = lane >> 4;
#pragma unroll 1
    for (int item = F.bid; item < 12 * 64; item += F.G) {
        const int bh = item >> 6, mphys = item & 63, b = bh / 6, h = bh % 6, rowbase = b * 8192 + mphys * 128;
        f32x4 oacc[2][4];
#pragma unroll
        for (int c = 0; c < 2; ++c)
#pragma unroll
            for (int j = 0; j < 4; ++j) oacc[c][j] = (f32x4){0.f, 0.f, 0.f, 0.f};
        float ld0 = 0.f, ld1 = 0.f;
        f32x4 Sacc[8];
#pragma unroll 1
        for (int k = 0; k < 4; ++k) {
            const int dir = k >> 1, c = dir ? 1 - (k & 1) : (k & 1);
            const _Float16* LFg = LF + (size_t)dir * MT * DH;
            if ((k & 1) == 0) {
                const int chain = bh * 2 + dir, m = dir ? 63 - mphys : mphys;
                const bf16_t* slot = DS + (size_t)(chain * 64 + m) * 16384;
#pragma unroll
                for (int dt = 0; dt < 8; ++dt) { const u32x2 w = *(const u32x2*)(slot + (16 * wid + r) * 128 + 16 * dt + 4 * q); Sacc[dt] = (f32x4){bf_lo(w.x), bf_hi(w.x), bf_lo(w.y), bf_hi(w.y)};
                    *(LAS u32x2*)(lds + ST_OFF + ((16 * wid + r) * RS128 + 16 * dt + 4 * q) * 2) = w; }
            }
            scan_chunk<true>(F, Qg, Vg, LFg, rowbase + 64 * c, h * 128, dir != 0, Sacc, oacc[0], ld0, ld1);
            if ((k & 1) == 0) {
#pragma unroll
                for (int j = 0; j < 4; ++j) { const f32x4 t = oacc[0][j]; oacc[0][j] = oacc[1][j]; oacc[1][j] = t; }
            }
        }
#pragma unroll
        for (int c = 0; c < 2; ++c)
#pragma unroll
            for (int j = 0; j < 4; ++j) { const f32x4 o = oacc[c][j]; float ss = o[0] * o[0] + o[1] * o[1] + o[2] * o[2] + o[3] * o[3]; ss += __shfl_xor(ss, 16); ss += __shfl_xor(ss, 32);
                if (q == 0) RED[(64 * c + 16 * j + r) * 8 + wid] = ss; }
        __syncthreads();
        const int col = h * 128 + 16 * wid + 4 * q; const f32x4 gn = *(const f32x4*)(hgrn_norm_g + col);
#pragma unroll
        for (int c = 0; c < 2; ++c)
#pragma unroll
            for (int j = 0; j < 4; ++j) { const int tok = 64 * c + 16 * j + r; const f32x4 s0 = *(const LAS f32x4*)(RED + tok * 8), s1 = *(const LAS f32x4*)(RED + tok * 8 + 4);
                const float ss = (s0[0] + s0[1]) + (s0[2] + s0[3]) + (s1[0] + s1[1]) + (s1[2] + s1[3]); const float rstd = 1.0f / sqrtf(ss * (1.0f / 128.0f) + EPS);
                const size_t row = (size_t)(rowbase + tok); const u32x2 gt = *(const u32x2*)(GT + row * DH + col); const f32x4 o = oacc[c][j];
                const float y0 = o[0] * rstd * gn[0] * bf_lo(gt.x), y1 = o[1] * rstd * gn[1] * bf_hi(gt.x), y2 = o[2] * rstd * gn[2] * bf_lo(gt.y), y3 = o[3] * rstd * gn[3] * bf_hi(gt.y);
                *(u32x2*)(HM + row * D + 256 + col) = (u32x2){cvt_pk_bf16(y0, y1), cvt_pk_bf16(y2, y3)}; }
        __syncthreads();
    }
}

__device__ __forceinline__ void pool_phase(const Frame& F, const float* pool_w, const float* pool_scale) {
    const float* PP = (const float*)(F.ws + WS_R + R_PP); bf16_t* HM = (bf16_t*)(F.ws + WS_H);
    LAS float* PL = (LAS float*)F.lds; LAS float* YL = (LAS float*)(F.lds + 65536);
    const int tid = F.tid;
    for (int item = F.bid; item < 256; item += F.G) {
        const int rowbase = item * 64;
        __syncthreads();
#pragma unroll
        for (int i = 0; i < 8; ++i) { const int e = (tid + NTHR * i) * 4, t = e >> 8, ch = e & 255; *(LAS f32x4*)(PL + t * 256 + ch) = *(const f32x4*)(PP + (size_t)(rowbase + t) * 256 + ch); }
        __syncthreads();
#pragma unroll
        for (int i = 0; i < 8; ++i) { const int e = (tid + NTHR * i) * 4, t = e >> 8, ch = e & 255, g = ch >> 6, w = 2 << g; int lo = t - (w >> 1), hi = lo + w; lo = lo < 0 ? 0 : lo; hi = hi > 64 ? 64 : hi;
            f32x4 s = {0.f, 0.f, 0.f, 0.f};
            for (int p = lo; p < hi; ++p) s += *(const LAS f32x4*)(PL + p * 256 + ch);
            const float inv = 1.0f / (float)(hi - lo);
            *(LAS f32x4*)(YL + t * 260 + ch) = s * inv - *(const LAS f32x4*)(PL + t * 256 + ch); }
        __syncthreads();
        const int t = tid >> 3, dq = tid & 7;
#pragma unroll 1
        for (int g = 0; g < 4; ++g) {
            f32x4 a0 = {0.f, 0.f, 0.f, 0.f}, a1 = a0; const float* wp = pool_w + (size_t)g * 4096 + dq * 8;
#pragma unroll 4
            for (int c = 0; c < 64; ++c) { const float y = YL[t * 260 + g * 64 + c]; a0 += *(const f32x4*)(wp + c * 64) * y; a1 += *(const f32x4*)(wp + c * 64 + 4) * y; }
            const f32x4 s0 = *(const f32x4*)(pool_scale + g * 64 + dq * 8), s1 = *(const f32x4*)(pool_scale + g * 64 + dq * 8 + 4);
            a0 *= s0; a1 *= s1;
            u32x4 w; w.x = cvt_pk_bf16(a0[0], a0[1]); w.y = cvt_pk_bf16(a0[2], a0[3]); w.z = cvt_pk_bf16(a1[0], a1[1]); w.w = cvt_pk_bf16(a1[2], a1[3]);
            *(u32x4*)(HM + (size_t)(rowbase + t) * D + g * 64 + dq * 8) = w;
        }
    }
    __syncthreads();
}

__device__ __forceinline__ void gmlp_phase(const Frame& F, const float* ln_g, const float* ln_b, const float* b_s) {
    const bf16_t* U = (const bf16_t*)(F.ws + WS_R + R_U); const bf16_t* VG = (const bf16_t*)(F.ws + WS_R + R_VG); const bf16_t* WSB = (const bf16_t*)(F.ws + WS_WS); bf16_t* HM = (bf16_t*)(F.ws + WS_H);
    LAS unsigned char* lds = F.lds; constexpr int VNT_OFF = 0, WSL_OFF = 34816, STAT_OFF = 69632;
    LAS float* STAT = (LAS float*)(lds + STAT_OFF);
    const int tid = F.tid, wid = F.wid, lane = F.lane, r = lane & 15, q = lane >> 4;
    for (int item = F.bid; item < 256; item += F.G) {
        const int n = item >> 1, gh = item & 1, rowbase = n * 128;
        __syncthreads();
        for (int i = 0; i < 16; ++i) { const int tk = 16 * wid + i; const bf16_t* p = VG + (size_t)(rowbase + tk) * D + lane * 16; const u32x4 a = *(const u32x4*)p, b2 = *(const u32x4*)(p + 8);
            float s = 0.f, ss = 0.f; const unsigned ws8[8] = {a.x, a.y, a.z, a.w, b2.x, b2.y, b2.z, b2.w};
#pragma unroll
            for (int k = 0; k < 8; ++k) { const float lo = bf_lo(ws8[k]), hi = bf_hi(ws8[k]); s += lo + hi; ss += lo * lo + hi * hi; }
#pragma unroll
            for (int o = 32; o >= 1; o >>= 1) { s += __shfl_xor(s, o); ss += __shfl_xor(ss, o); }
            const float mean = s * (1.0f / D); float var = ss * (1.0f / D) - mean * mean; var = var < 0.f ? 0.f : var;
            if (lane == 0) *(LAS f32x2*)(STAT + tk * 2) = (f32x2){mean, 1.0f / sqrtf(var + EPS)}; }
        __syncthreads();
#pragma unroll 1
        for (int gi = 0; gi < 4; ++gi) {
            const int g = gh * 4 + gi;
#pragma unroll
            for (int i = 0; i < 4; ++i) { const int id = tid + NTHR * i, p = id >> 4, q8 = (id & 15) * 8; *(LAS u32x4*)(lds + WSL_OFF + (p * RS128 + q8) * 2) = *(const u32x4*)(WSB + (size_t)g * 16384 + p * 128 + q8); }
            {
                const int c0 = g * 128 + 2 * lane; const f32x2 lg = *(const f32x2*)(ln_g + c0), lb2 = *(const f32x2*)(ln_b + c0);
                unsigned lo8[8], hi8[8]; float pl = 0.f, ph = 0.f;
#pragma unroll
                for (int i = 0; i < 16; ++i) { const int tk = 16 * wid + i; const unsigned x = *(const unsigned*)(VG + (size_t)(rowbase + tk) * D + c0); const f32x2 st = *(const LAS f32x2*)(STAT + tk * 2);
                    const float y0 = (bf_lo(x) - st.x) * st.y * lg.x + lb2.x, y1 = (bf_hi(x) - st.x) * st.y * lg.y + lb2.y;
                    if (i & 1) { lo8[i >> 1] = cvt_pk_bf16(pl, y0); hi8[i >> 1] = cvt_pk_bf16(ph, y1); } else { pl = y0; ph = y1; } }
                *(LAS u32x4*)(lds + VNT_OFF + ((2 * lane) * RS128 + 16 * wid) * 2) = (u32x4){lo8[0], lo8[1], lo8[2], lo8[3]}; *(LAS u32x4*)(lds + VNT_OFF + ((2 * lane) * RS128 + 16 * wid + 8) * 2) = (u32x4){lo8[4], lo8[5], lo8[6], lo8[7]};
                *(LAS u32x4*)(lds + VNT_OFF + ((2 * lane + 1) * RS128 + 16 * wid) * 2) = (u32x4){hi8[0], hi8[1], hi8[2], hi8[3]}; *(LAS u32x4*)(lds + VNT_OFF + ((2 * lane + 1) * RS128 + 16 * wid + 8) * 2) = (u32x4){hi8[4], hi8[5], hi8[6], hi8[7]};
            }
            __syncthreads();
            f32x4 acc[8];
#pragma unroll
            for (int ct = 0; ct < 8; ++ct) acc[ct] = (f32x4){0.f, 0.f, 0.f, 0.f};
#pragma unroll
            for (int kt = 0; kt < 4; ++kt) { const bf16x8 Qf = *(const LAS bf16x8*)(lds + WSL_OFF + ((16 * wid + r) * RS128 + kt * 32 + 8 * q) * 2);
#pragma unroll
                for (int ct = 0; ct < 8; ++ct) { const bf16x8 P = *(const LAS bf16x8*)(lds + VNT_OFF + ((16 * ct + r) * RS128 + kt * 32 + 8 * q) * 2); acc[ct] = mfma16(P, Qf, acc[ct]); } __builtin_amdgcn_sched_barrier(0); }
            const int tk = 16 * wid + r; const float bs = b_s[g * 128 + tk]; const size_t rowo = (size_t)(rowbase + tk) * D + g * 128 + 4 * q;
#pragma unroll
            for (int ct = 0; ct < 8; ++ct) { const u32x2 u2 = *(const u32x2*)(U + rowo + 16 * ct); const f32x4 a = acc[ct];
                *(u32x2*)(HM + rowo + 16 * ct) = (u32x2){cvt_pk_bf16(bf_lo(u2.x) * (a[0] + bs), bf_hi(u2.x) * (a[1] + bs)), cvt_pk_bf16(bf_lo(u2.y) * (a[2] + bs), bf_hi(u2.y) * (a[3] + bs))}; }
            __syncthreads();
        }
    }
}

__global__ void __launch_bounds__(NTHR) mega_fwd(Args args) {
    extern __shared__ __attribute__((aligned(16))) unsigned char lds_raw[];
    cg::grid_group grid = cg::this_grid();
    Frame F;
    F.lds = (LAS unsigned char*)lds_raw; F.tid = threadIdx.x; F.lane = F.tid & 63; F.wid = __builtin_amdgcn_readfirstlane(F.tid >> 6); F.G = gridDim.x; F.bid = blockIdx.x;
    F.out = args.out; F.ws = args.ws;
    unsigned char* ws = F.ws;
    float* XL = F.out; float* XC = (float*)(ws + WS_XC); bf16_t* H = (bf16_t*)(ws + WS_H); bf16_t* G = (bf16_t*)(ws + WS_R + R_G);
    const float* MOD0 = (const float*)(ws + WS_MOD); const float* MOD1 = MOD0 + 3 * NMODD;
    const int lo = args.ph_lo, hi = args.ph_hi;
#define IN(k) (lo <= (k) && (k) < hi)
#define SEAM(k) do { if (IN(k) && IN((k) + 1)) grid.sync(); } while (0)
    if (IN(0)) { mod_phase(F, args.in[1], args.in[3], args.in[4], args.in[5], args.in[19]); run_tjobs(F, args, 0); } SEAM(0);
    if (IN(1)) norm_phase(F, args.in[0], args.in[2], MT, args.in[6] + 0 * D, MOD0, 0, H); SEAM(1);
    if (IN(2)) run_gemm(F, H, (const bf16_t*)(ws + WS_UP0), MT, 2 * DFF, D, EpiSwiGlu{G}); SEAM(2);
    if (IN(3)) run_gemm(F, G, (const bf16_t*)(ws + WS_DN0), MT, D, DFF, EpiResid{args.in[0], args.in[2], XL, XC, MOD0 + 2 * 1024, 0.5f}); SEAM(3);
    if (IN(4)) norm_phase(F, XL, XC, MT, args.in[6] + 1 * D, MOD0, 1, H); SEAM(4);
    if (IN(5)) run_gemm(F, H, (const bf16_t*)(ws + WS_WIN), MT, DIN, D, EpiWin{ws + WS_R, args.in[13]}); SEAM(5);
    if (IN(6)) scan_pass1(F); SEAM(6);
    if (IN(7)) { scan_pass2(F); pool_phase(F, args.in[11], args.in[12]); } SEAM(7);
    if (IN(8)) scan_pass3(F, args.in[14]); SEAM(8);
    if (IN(9)) run_gemm(F, H, (const bf16_t*)(ws + WS_WOUT), ML, D, D, EpiResid{XL, XC, XL, XC, MOD0 + 5 * 1024, 1.0f}); SEAM(9);
    if (IN(10)) { norm_phase(F, XL, XC, ML, args.in[6] + 2 * D, MOD0, 2, H); run_tjobs(F, args, 1); } SEAM(10);
    if (IN(11)) run_gemm(F, H, (const bf16_t*)(ws + WS_UP0 + SZ_UP), ML, 2 * DFF, D, EpiSwiGlu{G}); SEAM(11);
    if (IN(12)) run_gemm(F, G, (const bf16_t*)(ws + WS_DN0 + SZ_DN), ML, D, DFF, EpiResid{XL, XC, XL, XC, MOD0 + 8 * 1024, 0.5f}); SEAM(12);
    if (IN(13)) norm_phase(F, XL, XC, ML, args.in[6] + 3 * D, MOD1, 0, H); SEAM(13);
    if (IN(14)) run_gemm(F, H, (const bf16_t*)(ws + WS_R + R_UP1), ML, 2 * DFF, D, EpiSwiGlu{G}); SEAM(14);
    if (IN(15)) run_gemm(F, G, (const bf16_t*)(ws + WS_R + R_DN1), ML, D, DFF, EpiResid{XL, XC, XL, XC, MOD1 + 2 * 1024, 0.5f}); SEAM(15);
    if (IN(16)) norm_phase(F, XL, XC, ML, args.in[6] + 4 * D, MOD1, 1, H); SEAM(16);
    if (IN(17)) run_gemm(F, H, (const bf16_t*)(ws + WS_GIN), ML, 2 * D, D, EpiGin{(bf16_t*)(ws + WS_R + R_U), (bf16_t*)(ws + WS_R + R_VG)}); SEAM(17);
    if (IN(18)) gmlp_phase(F, args.in[17], args.in[18], args.in[20]); SEAM(18);
    if (IN(19)) run_gemm(F, H, (const bf16_t*)(ws + WS_GOUT), ML, D, D, EpiResid{XL, XC, XL, XC, MOD1 + 5 * 1024, 1.0f}); SEAM(19);
    if (IN(20)) norm_phase(F, XL, XC, ML, args.in[6] + 5 * D, MOD1, 2, H); SEAM(20);
    if (IN(21)) run_gemm(F, H, (const bf16_t*)(ws + WS_R + R_UP1 + SZ_UP), ML, 2 * DFF, D, EpiSwiGlu{G}); SEAM(21);
    if (IN(22)) run_gemm(F, G, (const bf16_t*)(ws + WS_R + R_DN1 + SZ_DN), ML, D, DFF, EpiResid{XL, XC, XL, XC, MOD1 + 8 * 1024, 0.5f}); SEAM(22);
    if (IN(23)) final_norm_phase(F, XL, args.in[22]);
}
constexpr int NPHASES = 24;
#ifndef MK_PER_PHASE
#define MK_PER_PHASE 0
#endif

extern "C" void kernel_launch(void* const* d_in, const int* in_sizes, int n_in, void* d_out, int out_size, void* d_ws, size_t ws_size, hipStream_t stream) {
    static int grid = 0;
    if (grid == 0) {
        if (n_in != 23 || out_size != ML * D || ws_size < WS_END) { fprintf(stderr, "kernel_launch: unexpected shapes (n_in %d out %d ws %zu need %zu)\n", n_in, out_size, ws_size, (size_t)WS_END); grid = -1; return; }
        int dev = 0, cus = 0, per_cu = 0;
        hipGetDevice(&dev); hipDeviceGetAttribute(&cus, hipDeviceAttributeMultiprocessorCount, dev);
        hipFuncSetAttribute((const void*)mega_fwd, hipFuncAttributeMaxDynamicSharedMemorySize, LDS_BYTES);
        hipOccupancyMaxActiveBlocksPerMultiprocessor(&per_cu, (const void*)mega_fwd, NTHR, LDS_BYTES);
        if (per_cu < 1) { fprintf(stderr, "kernel_launch: occupancy query says %d blocks per CU\n", per_cu); per_cu = 1; }
        (void)hipGetLastError();
        grid = cus;
    }
    if (grid < 0) return;
    Args a{};
    for (int i = 0; i < 23; ++i) a.in[i] = (const float*)d_in[i];
    a.out = (float*)d_out; a.ws = (unsigned char*)d_ws;
#if MK_PER_PHASE
    for (int p = 0; p < NPHASES; ++p) { a.ph_lo = p; a.ph_hi = p + 1; hipLaunchKernelGGL(mega_fwd, dim3(grid), dim3(NTHR), LDS_BYTES, stream, a); }
#else
    a.ph_lo = 0; a.ph_hi = NPHASES;
    void* kargs[] = {&a};
    hipError_t e = hipLaunchCooperativeKernel((const void*)mega_fwd, dim3(grid), dim3(NTHR), kargs, LDS_BYTES, stream);
    if (e != hipSuccess) fprintf(stderr, "kernel_launch: cooperative launch failed: %s (grid %d)\n", hipGetErrorString(e), grid);
#endif
}
```

```cpp
#include <hip/hip_runtime.h>
#include <hip/hip_cooperative_groups.h>
#include <cstdio>
namespace cg = cooperative_groups;
namespace pg8 {
#define PG8_LAS __attribute__((address_space(3)))
typedef unsigned short bf16_t;
typedef short bf16x8 __attribute__((ext_vector_type(8)));
typedef float f32x4 __attribute__((ext_vector_type(4)));
typedef unsigned u32x4 __attribute__((ext_vector_type(4)));
constexpr int BM = 256, BK = 64, HALF = 128, HTB = HALF * BK * 2  , STAGE_BYTES = 8 * HTB, NXCD = 8, WGM = 8;

__host__ __device__ __forceinline__ int lds_byte(int r, int c) { const int st = (r >> 4) * 2 + (c >> 5), rr = r & 15, cc = c & 31, ob = rr * 64 + cc * 2; return st * 1024 + (ob ^ (((ob >> 9) & 1) << 5)); }
__host__ __device__ __forceinline__ void stage_rc(int b, int& R, int& C) { const int st = b / 1024, sb = b % 1024, swz = sb ^ (((sb >> 9) & 1) << 5); R = (st >> 1) * 16 + swz / 64; C = (st & 1) * 32 + (swz % 64) / 2; }
__host__ __device__ __forceinline__ int perm32(int rho) { const int n = rho >> 4, i = rho & 15; return 8 * (i >> 2) + 4 * n + (i & 3); }

struct Unit { int pm, pn; };
struct Gemm { const bf16_t* A; const bf16_t* Bt; int M, N, K, ld; };

struct StaticOrder {
    int nM, nN, nwg, G, c;
    __host__ __device__ void init(int M, int N, int G_, int c_) { nM = M / BM; nN = N / BM; nwg = nM * nN; G = G_; c = c_; }
    __host__ __device__ bool next(int i, Unit& u) const {
        const long L = (long)i * G + c; if (L >= nwg) return false;
        int wgid = (int)L; { const int q = nwg / NXCD, r = nwg % NXCD, xcd = wgid % NXCD, off = wgid / NXCD; wgid = (xcd < r ? xcd * (q + 1) : r * (q + 1) + (xcd - r) * q) + off; }
        const int nig = WGM * nN, gid = wgid / nig, fm = gid * WGM, gsz = (nM - fm) < WGM ? (nM - fm) : WGM;
        u.pm = fm + ((wgid % nig) % gsz); u.pn = (wgid % nig) / gsz; return true;
    }
    __device__ __forceinline__ void a_ready(const Unit&) const {}
    __device__ __forceinline__ void done(const Unit&) const {}
};
typedef __bf16 bf16v2_t __attribute__((ext_vector_type(2)));
typedef float f32v2_t __attribute__((ext_vector_type(2)));
__device__ __forceinline__ unsigned cvt_pk_bf16(float lo, float hi) { const f32v2_t v = {lo, hi}; const bf16v2_t b = __builtin_convertvector(v, bf16v2_t); return __builtin_bit_cast(unsigned, b); }
template <class Epi, class Sched, bool STAMP = false>
__device__ __forceinline__ void gemm_phase(PG8_LAS unsigned char* lds, const Gemm g, const Sched& S, const Epi& E, unsigned long long* stamps) {
    const int tid = threadIdx.x, wid = __builtin_amdgcn_readfirstlane(tid >> 6), lane = tid & 63, wr = wid >> 2, wc = wid & 3, fr = lane & 15, fq = lane >> 4;
    const int K = g.K, nt = K / BK, ld = g.ld;
    int ts_lo = 0, ts_hi = 0, nts = 0; const unsigned long long rt_entry = STAMP ? (unsigned long long)wall_clock64() : 0ull;
#define PG8_STAMP() do { if (STAMP && wid == 0 && nts < 64) { const unsigned long long _c = (unsigned long long)clock64(); \
        ts_lo = (lane == nts) ? (int)(unsigned)_c : ts_lo; ts_hi = (lane == nts) ? (int)(unsigned)(_c >> 32) : ts_hi; ++nts; } } while (0)
    PG8_STAMP();
    unsigned voffA[2], voffB[2];
#pragma unroll
    for (int i = 0; i < 2; ++i) { int R, C; stage_rc(tid * 16 + i * 8192, R, C); const int Rb = Epi::PERM ? ((R & ~31) + perm32(R & 31)) : R;
        voffA[i] = (unsigned)(R * ld + C) * 2u; voffB[i] = (unsigned)(Rb * ld + C) * 2u; }
    const size_t kstep = (size_t)(BK * 2);
    const size_t hstep = (size_t)HALF * ld * 2;
    const size_t tstep = 2 * hstep;
    const unsigned ldsw = (unsigned)wid * 1024u;
    const int aoff = lds_byte(wr * 64 + fr, fq * 8), boff = lds_byte(wc * 32 + fr, fq * 8);
#define PG8_SA(b, h) (((b) * 2 + (h)) * HTB)
#define PG8_SB(b, h) ((4 + (b) * 2 + (h)) * HTB)
#define PG8_STAGE(bufoff, gbase, voff) do { _Pragma("unroll") for (int _i = 0; _i < 2; ++_i) \
        __builtin_amdgcn_global_load_lds((const unsigned*)((const char*)(gbase) + (voff)[_i]), (PG8_LAS unsigned*)(lds + (bufoff) + ldsw + _i * 8192), 16, 0, 0); } while (0)
#define PG8_LDA(dst, b, h) do { _Pragma("unroll") for (int m = 0; m < 4; ++m) _Pragma("unroll") for (int k = 0; k < 2; ++k) dst[m][k] = *(const PG8_LAS bf16x8*)(lds + PG8_SA(b, h) + aoff + m * 2048 + k * 1024); } while (0)
#define PG8_LDB(dst, b, h) do { _Pragma("unroll") for (int n = 0; n < 2; ++n) _Pragma("unroll") for (int k = 0; k < 2; ++k) dst[n][k] = *(const PG8_LAS bf16x8*)(lds + PG8_SB(b, h) + boff + n * 2048 + k * 1024); } while (0)
#define PG8_MMA(ai, bj, At, Bt) do { __builtin_amdgcn_s_setprio(1); _Pragma("unroll") for (int m = 0; m < 4; ++m) _Pragma("unroll") for (int n = 0; n < 2; ++n) _Pragma("unroll") for (int k = 0; k < 2; ++k) \
        acc[ai][bj][m][n] = __builtin_amdgcn_mfma_f32_16x16x32_bf16(Bt[n][k], At[m][k], acc[ai][bj][m][n], 0, 0, 0); __builtin_amdgcn_s_setprio(0); } while (0)
#define PG8_WAIT_V(n) asm volatile("s_waitcnt vmcnt(" #n ")" ::: "memory")
#define PG8_WAIT_L(n) asm volatile("s_waitcnt lgkmcnt(" #n ")" ::: "memory")
#define PG8_BAR __builtin_amdgcn_s_barrier()
#define PG8_SCHED __builtin_amdgcn_sched_barrier(0)
    Unit cur, nxt; int ui = 0;
    if (!S.next(0, cur)) return;
    f32x4 acc[2][2][4][2];
#pragma unroll
    for (int a = 0; a < 2; ++a)
#pragma unroll
        for (int b = 0; b < 2; ++b)
#pragma unroll
            for (int m = 0; m < 4; ++m)
#pragma unroll
                for (int n = 0; n < 2; ++n) acc[a][b][m][n] = (f32x4){0.f, 0.f, 0.f, 0.f};
    bf16x8 At[4][2], B0[2][2], B1[2][2];
    const char* cA = (const char*)g.A + (size_t)cur.pm * tstep; const char* cB = (const char*)g.Bt + (size_t)cur.pn * tstep;
    S.a_ready(cur);
    PG8_STAGE(PG8_SB(0, 0), cB, voffB); PG8_STAGE(PG8_SA(0, 0), cA, voffA); PG8_STAGE(PG8_SB(0, 1), cB + hstep, voffB); PG8_STAGE(PG8_SA(0, 1), cA + hstep, voffA);
    if (wr == 1) PG8_BAR;
    PG8_WAIT_V(4); PG8_BAR;
    PG8_STAGE(PG8_SB(1, 0), cB + kstep, voffB); PG8_STAGE(PG8_SA(1, 0), cA + kstep, voffA); PG8_STAGE(PG8_SB(1, 1), cB + hstep + kstep, voffB);
    PG8_WAIT_V(6); PG8_BAR;
    PG8_STAMP();
    for (;;) {
        const bool has_next = S.next(ui + 1, nxt);
        const char* nA = has_next ? (const char*)g.A + (size_t)nxt.pm * tstep : cA; const char* nB = has_next ? (const char*)g.Bt + (size_t)nxt.pn * tstep : cB;
        for (int t = 0; t < nt; t += 2) {
            const bool last = (t == nt - 2);
            const char* a1 = cA + (size_t)(t + 1) * kstep;
            const char* a2 = last ? nA : cA + (size_t)(t + 2) * kstep; const char* b2 = last ? nB : cB + (size_t)(t + 2) * kstep;
            const char* a3 = a2 + kstep; const char* b3 = b2 + kstep;
            if (last && has_next) S.a_ready(nxt);
            PG8_LDB(B0, 0, 0); PG8_SCHED; PG8_LDA(At, 0, 0); PG8_STAGE(PG8_SA(1, 1), a1 + hstep, voffA);
            PG8_WAIT_L(8); PG8_BAR; PG8_WAIT_L(0); PG8_MMA(0, 0, At, B0); PG8_BAR; PG8_SCHED;
            PG8_LDB(B1, 0, 1); PG8_STAGE(PG8_SB(0, 0), b2, voffB);
            PG8_BAR; PG8_WAIT_L(0); PG8_MMA(0, 1, At, B1); PG8_BAR;
            PG8_LDA(At, 0, 1); PG8_STAGE(PG8_SA(0, 0), a2, voffA);
            PG8_BAR; PG8_WAIT_L(0); PG8_MMA(1, 0, At, B0); PG8_BAR; PG8_SCHED;
            PG8_STAGE(PG8_SB(0, 1), b2 + hstep, voffB);
            PG8_WAIT_V(6); PG8_BAR; PG8_MMA(1, 1, At, B1); PG8_BAR;
            PG8_LDB(B0, 1, 0); PG8_SCHED; PG8_LDA(At, 1, 0); PG8_STAGE(PG8_SA(0, 1), a2 + hstep, voffA);
            PG8_WAIT_L(8); PG8_BAR; PG8_WAIT_L(0); PG8_MMA(0, 0, At, B0); PG8_BAR; PG8_SCHED;
            PG8_LDB(B1, 1, 1); PG8_STAGE(PG8_SB(1, 0), b3, voffB);
            PG8_BAR; PG8_WAIT_L(0); PG8_MMA(0, 1, At, B1); PG8_BAR;
            PG8_LDA(At, 1, 1); PG8_STAGE(PG8_SA(1, 0), a3, voffA);
            PG8_BAR; PG8_WAIT_L(0); PG8_MMA(1, 0, At, B0); PG8_BAR; PG8_SCHED;
            PG8_STAGE(PG8_SB(1, 1), b3 + hstep, voffB);
            PG8_WAIT_V(6); PG8_BAR; PG8_MMA(1, 1, At, B1); PG8_BAR;
        }
        PG8_STAMP();
        if constexpr (!Epi::AFTER_DRAIN) { E(acc, cur, wr, wc, fr, fq); S.done(cur); }
        PG8_STAMP();
        if (!has_next) break;
#pragma unroll
        for (int a = 0; a < 2; ++a)
#pragma unroll
            for (int b = 0; b < 2; ++b)
#pragma unroll
                for (int m = 0; m < 4; ++m)
#pragma unroll
                    for (int n = 0; n < 2; ++n) acc[a][b][m][n] = (f32x4){0.f, 0.f, 0.f, 0.f};
        cur = nxt; cA = nA; cB = nB; ++ui;
    }
    PG8_WAIT_V(0);
    if (wr == 0) PG8_BAR;
    PG8_BAR;
    if constexpr (Epi::AFTER_DRAIN) { E.fused(acc, cur, wr, wc, fr, fq, lds, wid, lane); S.done(cur); }
    PG8_STAMP();
    if (STAMP && wid == 0) { stamps[lane] = lane < nts ? (((unsigned long long)(unsigned)ts_hi << 32) | (unsigned)ts_lo) : 0ull;
        if (lane == 62) stamps[62] = rt_entry; if (lane == 63) stamps[63] = (unsigned long long)wall_clock64(); }
#undef PG8_STAMP
#undef PG8_SA
#undef PG8_SB
#undef PG8_STAGE
#undef PG8_LDA
#undef PG8_LDB
#undef PG8_MMA
#undef PG8_WAIT_V
#undef PG8_WAIT_L
#undef PG8_BAR
#undef PG8_SCHED
}
}

using pg8::bf16_t; using pg8::bf16x8; using pg8::f32x4; using pg8::u32x4; using pg8::Unit; using pg8::cvt_pk_bf16;
#define LAS __attribute__((address_space(3)))
typedef float f32x2 __attribute__((ext_vector_type(2)));
typedef unsigned u32x2 __attribute__((ext_vector_type(2)));
typedef _Float16 f16x2 __attribute__((ext_vector_type(2)));
typedef _Float16 f16x8 __attribute__((ext_vector_type(8)));

constexpr int D = 1024, ML = 16384, MC = 512, MT = ML + MC, DFF = 2816, DH = 768, DIN = 4096, NMODD = 9 * 1024;
constexpr float EPS = 1e-6f;
constexpr int NTHR = 512;
constexpr int LDS_BYTES = 147456;

constexpr size_t al256(size_t x) { return (x + 255) & ~(size_t)255; }
constexpr size_t WS_BAR   = 4096;
constexpr size_t WS_MOD   = 4096 + 16384;
constexpr size_t WS_XC    = al256(WS_MOD + (size_t)2 * 3 * NMODD * 4);
constexpr size_t SZ_UP    = (size_t)2 * DFF * D * 2;
constexpr size_t SZ_DN    = (size_t)D * DFF * 2;
constexpr size_t WS_UP0   = al256(WS_XC + (size_t)MC * D * 4);
constexpr size_t WS_DN0   = WS_UP0 + 2 * SZ_UP;
constexpr size_t WS_WIN   = WS_DN0 + 2 * SZ_DN;
constexpr size_t WS_WOUT  = WS_WIN + (size_t)DIN * D * 2;
constexpr size_t WS_GIN   = WS_WOUT + (size_t)D * D * 2;
constexpr size_t WS_GOUT  = WS_GIN + (size_t)2 * D * D * 2;
constexpr size_t WS_WS    = WS_GOUT + (size_t)D * D * 2;
constexpr size_t WS_H     = al256(WS_WS + (size_t)8 * 128 * 128 * 2);
constexpr size_t WS_R     = al256(WS_H + (size_t)MT * D * 2);
constexpr size_t R_G      = 0;
constexpr size_t R_UP1    = al256((size_t)MT * DFF * 2 + 4096);
constexpr size_t R_DN1    = R_UP1 + 2 * SZ_UP;
constexpr size_t R_FFN_END = R_DN1 + 2 * SZ_DN;
constexpr size_t R_PART   = R_UP1;
constexpr size_t R_PP     = 0;
constexpr size_t R_Q      = al256(R_PP + (size_t)MT * 256 * 4);
constexpr size_t R_V      = al256(R_Q + (size_t)MT * DH * 2);
constexpr size_t R_GT     = al256(R_V + (size_t)MT * DH * 2);
constexpr size_t R_LF     = al256(R_GT + (size_t)MT * DH * 2);
constexpr size_t R_DS     = al256(R_LF + (size_t)2 * MT * DH * 2);
constexpr size_t R_DEC    = al256(R_DS + (size_t)1536 * 16384 * 2);
constexpr size_t R_AB_END = al256(R_DEC + (size_t)1536 * 128 * 4);
constexpr size_t R_U      = 0;
constexpr size_t R_VG     = (size_t)ML * D * 2;
constexpr size_t R_SIZE   = R_AB_END > R_FFN_END ? R_AB_END : R_FFN_END;
constexpr size_t WS_END   = WS_R + R_SIZE;

struct Args {
    const float* in[23]; float* out; unsigned char* ws; int ph_lo, ph_hi;
};

struct Frame {
    LAS unsigned char* lds; int tid, lane, wid, G, bid;
    float* out; unsigned char* ws;
};

__device__ __forceinline__ float bf_lo(unsigned w) { return __uint_as_float(w << 16); }
__device__ __forceinline__ float bf_hi(unsigned w) { return __uint_as_float(w & 0xffff0000u); }
__device__ __forceinline__ float fast_rcp(float x) { return __builtin_amdgcn_rcpf(x); }
__device__ __forceinline__ float sigmoidf_(float x) { return fast_rcp(1.0f + __expf(-x)); }
__device__ __forceinline__ float siluf_(float x) { return x * sigmoidf_(x); }
__device__ __forceinline__ float gelu_tanh(float x) { const float u = 0.7978845608f * (x + 0.044715f * x * x * x); return x * sigmoidf_(2.0f * u); }
__device__ __forceinline__ f32x4 mfma16(bf16x8 a, bf16x8 b, f32x4 c) { return __builtin_amdgcn_mfma_f32_16x16x32_bf16(a, b, c, 0, 0, 0); }

struct EpiSwiGlu {
    static constexpr bool PERM = true, AFTER_DRAIN = false;
    bf16_t* G;
    __device__ __forceinline__ void operator()(const f32x4 (&acc)[2][2][4][2], const Unit& u, int wr, int wc, int fr, int fq) const {
        const int row0 = u.pm * 256 + wr * 64 + fr, col0 = u.pn * 128 + wc * 32 + 8 * fq;
#pragma unroll
        for (int ai = 0; ai < 2; ++ai)
#pragma unroll
            for (int m = 0; m < 4; ++m) {
                bf16_t* p = G + (size_t)(row0 + ai * 128 + m * 16) * DFF + col0;
                const f32x4 a0 = acc[ai][0][m][0], a1 = acc[ai][0][m][1], b0 = acc[ai][1][m][0], b1 = acc[ai][1][m][1];
                u32x4 w;
                w.x = cvt_pk_bf16(siluf_(a0[0]) * b0[0], siluf_(a0[1]) * b0[1]); w.y = cvt_pk_bf16(siluf_(a0[2]) * b0[2], siluf_(a0[3]) * b0[3]);
                w.z = cvt_pk_bf16(siluf_(a1[0]) * b1[0], siluf_(a1[1]) * b1[1]); w.w = cvt_pk_bf16(siluf_(a1[2]) * b1[2], siluf_(a1[3]) * b1[3]);
                *(u32x4*)p = w;
            }
    }
};
struct EpiResid {
    static constexpr bool PERM = false, AFTER_DRAIN = false;
    const float* baseL; const float* baseC; float* outL; float* outC; const float* gate  ; float scale;
    __device__ __forceinline__ void operator()(const f32x4 (&acc)[2][2][4][2], const Unit& u, int wr, int wc, int fr, int fq) const {
        const bool isc = u.pm >= 64; const int vec = isc ? 2 : (u.pm >> 5);
        const int row0 = (isc ? (u.pm - 64) * 256 : u.pm * 256) + wr * 64 + fr, col0 = u.pn * 256 + wc * 32 + 4 * fq;
        const float* base = isc ? baseC : baseL; float* out = isc ? outC : outL;
        f32x4 gv[4];
#pragma unroll
        for (int g = 0; g < 4; ++g) gv[g] = *(const f32x4*)(gate + (size_t)vec * NMODD + col0 + (g >> 1) * 128 + (g & 1) * 16) * scale;
        f32x4 A[4], B[4];
#pragma unroll
        for (int m = 0; m < 4; ++m) A[m] = *(const f32x4*)(base + (size_t)(row0 + m * 16) * D + col0);
#pragma unroll
        for (int step = 0; step < 8; ++step) {
            const int g = step >> 1, hh = step & 1, bj = g >> 1, n = g & 1, cg = col0 + bj * 128 + n * 16;
            if (step < 7) { const int s2 = step + 1, g2 = s2 >> 1, h2 = s2 & 1, cn = col0 + (g2 >> 1) * 128 + (g2 & 1) * 16;
#pragma unroll
                for (int m = 0; m < 4; ++m) { const f32x4 t = *(const f32x4*)(base + (size_t)(row0 + h2 * 128 + m * 16) * D + cn); if (step & 1) A[m] = t; else B[m] = t; } }
            __builtin_amdgcn_sched_barrier(0);
#pragma unroll
            for (int m = 0; m < 4; ++m) *(f32x4*)(out + (size_t)(row0 + hh * 128 + m * 16) * D + cg) = ((step & 1) ? B[m] : A[m]) + gv[g] * acc[hh][bj][m][n];
            __builtin_amdgcn_sched_barrier(0);
        }
    }
};
struct EpiWin {
    static constexpr bool PERM = true, AFTER_DRAIN = false;
    unsigned char* R  ; const float* lb  ;
    __device__ __forceinline__ void operator()(const f32x4 (&acc)[2][2][4][2], const Unit& u, int wr, int wc, int fr, int fq) const {
        const int row0 = u.pm * 256 + wr * 64 + fr, cw = wc * 32 + 8 * fq;
        const int pn = u.pn;
        if (pn == 0) {
#pragma unroll
            for (int ai = 0; ai < 2; ++ai)
#pragma unroll
                for (int m = 0; m < 4; ++m) { float* p = (float*)(R + R_PP) + (size_t)(row0 + ai * 128 + m * 16) * 256 + cw;
#pragma unroll
                    for (int bj = 0; bj < 2; ++bj) { *(f32x4*)(p + bj * 128) = acc[ai][bj][m][0]; *(f32x4*)(p + bj * 128 + 4) = acc[ai][bj][m][1]; } }
            return;
        }
        const int sec = (pn - 1) / 3, scol = ((pn - 1) % 3) * 256 + cw;
        if (sec == 2 || sec == 3) {
            const int dir = sec - 2; _Float16* O = (_Float16*)(R + R_LF) + (size_t)dir * MT * DH;
#pragma unroll
            for (int bj = 0; bj < 2; ++bj) {
                float lbv[8];
#pragma unroll
                for (int e = 0; e < 8; ++e) { const int c = scol + bj * 128 + e; const float l0 = lb[dir * DH + c], l1 = lb[2 * DH + dir * DH + c]; lbv[e] = fast_rcp(1.0f + __expf(l1 - l0)); }
#pragma unroll
                for (int ai = 0; ai < 2; ++ai)
#pragma unroll
                    for (int m = 0; m < 4; ++m) { _Float16* p = O + (size_t)(row0 + ai * 128 + m * 16) * DH + scol; f16x8 w;
#pragma unroll
                        for (int e = 0; e < 8; ++e) { const float a = acc[ai][bj][m][e >> 2][e & 3]; const float l = lbv[e]; w[e] = (_Float16)fminf((1.0f - l) * fast_rcp(1.0f + __expf(a)), 0.9995f); }
                        *(f16x8*)(p + bj * 128) = w; }
                __builtin_amdgcn_sched_barrier(0);
            }
            return;
        }
        const size_t ooff = sec == 0 ? R_Q : (sec == 1 ? R_V : R_GT); bf16_t* O = (bf16_t*)(R + ooff);
#pragma unroll
        for (int ai = 0; ai < 2; ++ai)
#pragma unroll
            for (int m = 0; m < 4; ++m) { bf16_t* p = O + (size_t)(row0 + ai * 128 + m * 16) * DH + scol;
#pragma unroll
                for (int bj = 0; bj < 2; ++bj) { float v[8];
#pragma unroll
                    for (int e = 0; e < 8; ++e) { const float a = acc[ai][bj][m][e >> 2][e & 3]; v[e] = sec == 0 ? siluf_(a) * 0.08838834764831845f : (sec == 1 ? a : siluf_(a)); }
                    u32x4 w; w.x = cvt_pk_bf16(v[0], v[1]); w.y = cvt_pk_bf16(v[2], v[3]); w.z = cvt_pk_bf16(v[4], v[5]); w.w = cvt_pk_bf16(v[6], v[7]);
                    *(u32x4*)(p + bj * 128) = w; } }
    }
};
struct EpiGin {
    static constexpr bool PERM = true, AFTER_DRAIN = false;
    bf16_t* U; bf16_t* VG;
    __device__ __forceinline__ void operator()(const f32x4 (&acc)[2][2][4][2], const Unit& u, int wr, int wc, int fr, int fq) const {
        const int row0 = u.pm * 256 + wr * 64 + fr; bf16_t* O = u.pn < 4 ? U : VG; const int col0 = (u.pn & 3) * 256 + wc * 32 + 8 * fq;
#pragma unroll
        for (int ai = 0; ai < 2; ++ai)
#pragma unroll
            for (int m = 0; m < 4; ++m) { bf16_t* p = O + (size_t)(row0 + ai * 128 + m * 16) * D + col0;
#pragma unroll
                for (int bj = 0; bj < 2; ++bj) { const f32x4 a0 = acc[ai][bj][m][0], a1 = acc[ai][bj][m][1]; u32x4 w;
                    w.x = cvt_pk_bf16(gelu_tanh(a0[0]), gelu_tanh(a0[1])); w.y = cvt_pk_bf16(gelu_tanh(a0[2]), gelu_tanh(a0[3]));
                    w.z = cvt_pk_bf16(gelu_tanh(a1[0]), gelu_tanh(a1[1])); w.w = cvt_pk_bf16(gelu_tanh(a1[2]), gelu_tanh(a1[3]));
                    *(u32x4*)(p + bj * 128) = w; } }
    }
};

template <class Epi>
__device__ __forceinline__ void run_gemm(const Frame& F, const bf16_t* A, const bf16_t* Bt, int M, int N, int K, const Epi& E) {
    pg8::StaticOrder S; S.init(M, N, F.G, F.bid);
    pg8::Gemm g; g.A = A; g.Bt = Bt; g.M = M; g.N = N; g.K = K; g.ld = K;
    pg8::gemm_phase<Epi, pg8::StaticOrder, false>(F.lds, g, S, E, nullptr);
    __syncthreads();
}

struct OneUnit {
    int pm, pn; bool on;
    __device__ bool next(int i, Unit& u) const { if (i != 0 || !on) return false; u.pm = pm; u.pn = pn; return true; }
    __device__ __forceinline__ void a_ready(const Unit&) const {}
    __device__ __forceinline__ void done(const Unit&) const {}
};
struct EpiPartCtx {
    static constexpr bool PERM = false, AFTER_DRAIN = false;
    float* part;
    __device__ __forceinline__ void operator()(const f32x4 (&acc)[2][2][4][2], const Unit& u, int wr, int wc, int fr, int fq) const {
        const int row0 = u.pm * 256 + wr * 64 + fr, col0 = u.pn * 256 + wc * 32 + 4 * fq;
#pragma unroll
        for (int ai = 0; ai < 2; ++ai)
#pragma unroll
            for (int m = 0; m < 4; ++m) { float* p = part + (size_t)(row0 + ai * 128 + m * 16) * D + col0;
#pragma unroll
                for (int bj = 0; bj < 2; ++bj)
#pragma unroll
                    for (int n = 0; n < 2; ++n) *(f32x4*)(p + bj * 128 + n * 16) = acc[ai][bj][m][n]; }
    }
};
__device__ __forceinline__ void run_ctx_down_splitk(const Frame& F, const bf16_t* Gctx  , const bf16_t* Bt, float* part) {
    const int ks = F.bid % 11, tile = F.bid / 11;
    OneUnit S; S.on = F.bid < 88; S.pm = tile >> 2; S.pn = tile & 3;
    pg8::Gemm g; g.A = Gctx + ks * 256; g.Bt = Bt + ks * 256; g.M = MC; g.N = D; g.K = 256; g.ld = DFF;
    EpiPartCtx E; E.part = part + (size_t)ks * MC * D;
    pg8::gemm_phase<EpiPartCtx, OneUnit, false>(F.lds, g, S, E, nullptr);
    __syncthreads();
}

__device__ __forceinline__ void transpose_tile(const Frame& F, const float* W, bf16_t* Bt, int K, int N, int mode, int tile) {
    LAS float* T = (LAS float*)F.lds;
    const int ntn = N >> 8, tk = tile / ntn, tn = tile % ntn, k0 = tk * 64, n0 = tn * 256;
    const int tid = F.tid;
    __syncthreads();
    f32x4 v[8];
#pragma unroll
    for (int i = 0; i < 8; ++i) { const int id = tid + NTHR * i, r = id >> 6, c4 = (id & 63) * 4; v[i] = *(const f32x4*)(W + (size_t)(k0 + r) * N + n0 + c4); }
#pragma unroll
    for (int i = 0; i < 8; ++i) { const int id = tid + NTHR * i, r = id >> 6, c4 = (id & 63) * 4; LAS float* p = T + r * 257 + c4; p[0] = v[i][0]; p[1] = v[i][1]; p[2] = v[i][2]; p[3] = v[i][3]; }
    __syncthreads();
#pragma unroll
    for (int j = 0; j < 4; ++j) { const int id = tid + NTHR * j, nl = id >> 3, k8 = (id & 7) * 8;
        const float v0 = T[(k8 + 0) * 257 + nl], v1 = T[(k8 + 1) * 257 + nl], v2 = T[(k8 + 2) * 257 + nl], v3 = T[(k8 + 3) * 257 + nl], v4 = T[(k8 + 4) * 257 + nl], v5 = T[(k8 + 5) * 257 + nl], v6 = T[(k8 + 6) * 257 + nl], v7 = T[(k8 + 7) * 257 + nl];
        const int n = n0 + nl; const int row = mode == 0 ? n : ((n >> 7) * 256 + (n & 127) + (mode == 2 ? 128 : 0));
        u32x4 w; w.x = cvt_pk_bf16(v0, v1); w.y = cvt_pk_bf16(v2, v3); w.z = cvt_pk_bf16(v4, v5); w.w = cvt_pk_bf16(v6, v7);
        *(u32x4*)(Bt + (size_t)row * K + k0 + k8) = w; }
}
__device__ __forceinline__ void do_tjob(const Frame& F, const Args& A, int set, int i, int tile) {
    const int layer = set;
    unsigned char* upb = set == 0 ? F.ws + WS_UP0 : F.ws + WS_R + R_UP1; unsigned char* dnb = set == 0 ? F.ws + WS_DN0 : F.ws + WS_R + R_DN1;
    const float* W; bf16_t* Bt; int K, N, mode;
    if (i < 4) { const int f = i >> 1, which = i & 1; W = (which ? A.in[8] : A.in[7]) + (size_t)(layer * 2 + f) * D * DFF; Bt = (bf16_t*)(upb + (size_t)f * SZ_UP); K = D; N = DFF; mode = 1 + which; }
    else if (i < 6) { const int f = i - 4; W = A.in[9] + (size_t)(layer * 2 + f) * DFF * D; Bt = (bf16_t*)(dnb + (size_t)f * SZ_DN); K = DFF; N = D; mode = 0; }
    else if (i == 6) { W = A.in[10]; Bt = (bf16_t*)(F.ws + WS_WIN); K = D; N = DIN; mode = 0; }
    else if (i == 7) { W = A.in[15]; Bt = (bf16_t*)(F.ws + WS_WOUT); K = D; N = D; mode = 0; }
    else if (i == 8) { W = A.in[16]; Bt = (bf16_t*)(F.ws + WS_GIN); K = D; N = 2 * D; mode = 0; }
    else { W = A.in[21]; Bt = (bf16_t*)(F.ws + WS_GOUT); K = D; N = D; mode = 0; }
    transpose_tile(F, W, Bt, K, N, mode, tile);
}
__device__ __forceinline__ int tjob_tiles(int i) { return i < 6 ? 176 : (i == 6 ? 256 : (i == 8 ? 128 : 64)); }
__device__ __forceinline__ void run_tjobs(const Frame& F, const Args& A, int set, unsigned jobmask, int first_wg, int n_wgs) {
    const int nj = set == 0 ? 10 : 6;
    if (F.bid >= first_wg && F.bid < first_wg + n_wgs) {
        int total = 0;
        for (int i = 0; i < nj; ++i) if ((jobmask >> i) & 1u) total += tjob_tiles(i);
        for (int t = F.bid - first_wg; t < total; t += n_wgs) {
            int rem = t, ji = 0; bool found = false;
            for (int i = 0; i < nj; ++i) if (((jobmask >> i) & 1u) && !found) { const int cnt = tjob_tiles(i); if (rem < cnt) { ji = i; found = true; } else rem -= cnt; }
            do_tjob(F, A, set, ji, rem);
        }
    }
    __syncthreads();
}


__device__ __forceinline__ void mod_phase(const Frame& F, const float* c_in, const float* c_ctx, const float* mod_w, const float* mod_b, const float* w_s) {
    LAS float* SC = (LAS float*)F.lds;
    LAS float* RED = (LAS float*)(F.lds + 3 * 1024 * 4);
    const int tid = F.tid;
    __syncthreads();
    for (int i = tid; i < 3 * 1024; i += NTHR) { const int v = i >> 10, k = i & 1023; const float c = v < 2 ? c_in[v * 1024 + k] : c_ctx[k]; SC[i] = siluf_(c); }
    __syncthreads();
    float* MOD = (float*)(F.ws + WS_MOD);
    const int cg4 = tid & 15, ks = tid >> 4;
    for (int item = F.bid; item < 2 * 144; item += F.G) {
        const int l = item / 144, n0 = (item % 144) * 64;
        const float* W = mod_w + (size_t)l * D * NMODD + n0 + cg4 * 4;
        f32x4 a0 = {0.f, 0.f, 0.f, 0.f}, a1 = a0, a2 = a0;
#pragma unroll 8
        for (int r = 0; r < 32; ++r) { const int k = ks * 32 + r; const f32x4 w = *(const f32x4*)(W + (size_t)k * NMODD); a0 += w * SC[k]; a1 += w * SC[1024 + k]; a2 += w * SC[2048 + k]; }
        __syncthreads();
        *(LAS f32x4*)(RED + (ks * 3 + 0) * 64 + cg4 * 4) = a0; *(LAS f32x4*)(RED + (ks * 3 + 1) * 64 + cg4 * 4) = a1; *(LAS f32x4*)(RED + (ks * 3 + 2) * 64 + cg4 * 4) = a2;
        __syncthreads();
        if (tid < 192) { const int v = tid >> 6, c = tid & 63; float s = 0.f;
            for (int k2 = 0; k2 < 32; ++k2) s += RED[(k2 * 3 + v) * 64 + c];
            MOD[(size_t)(l * 3 + v) * NMODD + n0 + c] = s + mod_b[(size_t)l * NMODD + n0 + c]; }
    }
    __syncthreads();
    bf16_t* WSB = (bf16_t*)(F.ws + WS_WS);
    for (int i = (F.bid * NTHR + tid) * 2; i < 8 * 128 * 128; i += F.G * NTHR * 2) { const f32x2 v = *(const f32x2*)(w_s + i); *(unsigned*)(WSB + i) = cvt_pk_bf16(v.x, v.y); }
}

__device__ __forceinline__ void norm_phase(const Frame& F, const float* xl, const float* xc, int nrows, const float* g, const float* modl, int s, bf16_t* H, const float* part = nullptr, const float* pgate = nullptr) {
    const int lane = F.lane, stride = F.G * 8;
    for (int row0 = F.bid * 8 + F.wid; row0 < nrows; row0 += 2 * stride) {
        f32x4 v[2][4]; float ss[2];
#pragma unroll
        for (int t = 0; t < 2; ++t) { const int row = row0 + t * stride; const bool ok = row < nrows; const int rr = ok ? row : row0;
            const float* src = rr < ML ? xl + (size_t)rr * D : xc + (size_t)(rr - ML) * D;
#pragma unroll
            for (int i = 0; i < 4; ++i) v[t][i] = *(const f32x4*)(src + i * 256 + lane * 4);
            if (part != nullptr && rr >= ML) {
#pragma unroll
                for (int i = 0; i < 4; ++i) { f32x4 a = {0.f, 0.f, 0.f, 0.f};
#pragma unroll
                    for (int ks = 0; ks < 11; ++ks) a += *(const f32x4*)(part + ((size_t)ks * MC + (rr - ML)) * D + i * 256 + lane * 4);
                    v[t][i] += a * (*(const f32x4*)(pgate + i * 256 + lane * 4) * 0.5f); } }
        }
#pragma unroll
        for (int t = 0; t < 2; ++t) { float q = 0.f;
#pragma unroll
            for (int i = 0; i < 4; ++i) q += v[t][i][0] * v[t][i][0] + v[t][i][1] * v[t][i][1] + v[t][i][2] * v[t][i][2] + v[t][i][3] * v[t][i][3];
#pragma unroll
            for (int o = 32; o >= 1; o >>= 1) q += __shfl_xor(q, o);
            ss[t] = q; }
#pragma unroll
        for (int t = 0; t < 2; ++t) { const int row = row0 + t * stride; if (row < nrows) {
            const int vec = row < 8192 ? 0 : (row < ML ? 1 : 2);
            const float rstd = 1.0f / sqrtf(ss[t] * (1.0f / D) + EPS);
            const float* sc = modl + (size_t)vec * NMODD + (3 * s + 1) * 1024; const float* sh = modl + (size_t)vec * NMODD + (3 * s) * 1024;
            f32x4 gg[4], s4[4], h4[4];
#pragma unroll
            for (int i = 0; i < 4; ++i) { const int c = i * 256 + lane * 4; gg[i] = *(const f32x4*)(g + c); s4[i] = *(const f32x4*)(sc + c); h4[i] = *(const f32x4*)(sh + c); }
#pragma unroll
            for (int i = 0; i < 4; ++i) { const int c = i * 256 + lane * 4;
                const f32x4 y = (v[t][i] * rstd) * gg[i] * (s4[i] + 1.0f) + h4[i]; u32x2 w; w.x = cvt_pk_bf16(y[0], y[1]); w.y = cvt_pk_bf16(y[2], y[3]); *(u32x2*)(H + (size_t)row * D + c) = w; } } }
    }
}
__device__ __forceinline__ void final_norm_phase(const Frame& F, float* x, const float* g) {
    const int lane = F.lane, stride = F.G * 8;
    f32x4 gg[4];
#pragma unroll
    for (int i = 0; i < 4; ++i) gg[i] = *(const f32x4*)(g + i * 256 + lane * 4);
    for (int row0 = F.bid * 8 + F.wid; row0 < ML; row0 += 2 * stride) {
        f32x4 v[2][4];
#pragma unroll
        for (int t = 0; t < 2; ++t) { const int row = row0 + t * stride; const int rr = row < ML ? row : row0;
#pragma unroll
            for (int i = 0; i < 4; ++i) v[t][i] = *(const f32x4*)(x + (size_t)rr * D + i * 256 + lane * 4); }
#pragma unroll
        for (int t = 0; t < 2; ++t) { const int row = row0 + t * stride; float q = 0.f;
#pragma unroll
            for (int i = 0; i < 4; ++i) q += v[t][i][0] * v[t][i][0] + v[t][i][1] * v[t][i][1] + v[t][i][2] * v[t][i][2] + v[t][i][3] * v[t][i][3];
#pragma unroll
            for (int o = 32; o >= 1; o >>= 1) q += __shfl_xor(q, o);
            const float rstd = 1.0f / sqrtf(q * (1.0f / D) + EPS);
            if (row < ML) {
#pragma unroll
                for (int i = 0; i < 4; ++i) { const int c = i * 256 + lane * 4; *(f32x4*)(x + (size_t)row * D + c) = (v[t][i] * rstd) * gg[i]; } } }
    }
}

constexpr int RS128 = 136, RS64 = 72;
constexpr int QE_OFF = 0, KE_OFF = 17408, QD_OFF = 34816, KDT_OFF = 52224, VT_OFF = 70656, AL_OFF = 89088, ST_OFF = 98304, TOT_OFF = 133120, BL_OFF = 137216, RED_OFF = 137728;

struct ScanPre { unsigned lf[8], v[8], q[8]; };
template <bool OUT>
__device__ __forceinline__ void scan_load(const Frame& F, ScanPre& P, const bf16_t* Qg, const bf16_t* Vg, const _Float16* LFg, int row0, int hcol) {
    const int c0 = hcol + 2 * F.lane;
#pragma unroll
    for (int i = 0; i < 8; ++i) { const size_t ro = (size_t)(row0 + 8 * F.wid + i) * DH + c0; P.lf[i] = *(const unsigned*)(LFg + ro); P.v[i] = *(const unsigned*)(Vg + ro); P.q[i] = OUT ? *(const unsigned*)(Qg + ro) : 0u; }
}
template <bool OUT>
__device__ __forceinline__ void scan_chunk(const Frame& F, const ScanPre& P, ScanPre& N, bool has_next, const bf16_t* Qg, const bf16_t* Vg, const _Float16* nLFg, int nrow0, int nhcol, bool rev, f32x4 (&Sacc)[8], f32x4 (&oacc)[4], float& ld0, float& ld1) {
    LAS unsigned char* lds = F.lds; const int wid = F.wid, lane = F.lane, r = lane & 15, q = lane >> 4;
    LAS float* TOT = (LAS float*)(lds + TOT_OFF); LAS float* BL = (LAS float*)(lds + BL_OFF);
    float c_0[8], c_1[8], lf0[8], lf1[8]; unsigned qv[8], vv[8];
    float kk0[8], kk1[8];
#pragma unroll
    for (int i = 0; i < 8; ++i) { const f16x2 h = __builtin_bit_cast(f16x2, P.lf[i]); kk0[i] = (float)h.x; kk1[i] = (float)h.y; lf0[i] = __logf(1.0f - kk0[i]); lf1[i] = __logf(1.0f - kk1[i]); vv[i] = P.v[i]; qv[i] = P.q[i]; }
    float t0 = 0.f, t1 = 0.f;
    if (!rev) {
#pragma unroll
        for (int i = 0; i < 8; ++i) { t0 += lf0[i]; t1 += lf1[i]; c_0[i] = t0; c_1[i] = t1; }
    } else {
#pragma unroll
        for (int i = 7; i >= 0; --i) { t0 += lf0[i]; t1 += lf1[i]; c_0[i] = t0; c_1[i] = t1; }
    }
    *(LAS f32x2*)(TOT + wid * 128 + 2 * lane) = (f32x2){t0, t1};
    __syncthreads();
    __builtin_amdgcn_sched_barrier(0);
    float off0 = 0.f, off1 = 0.f, mid0 = 0.f, mid1 = 0.f, last0 = 0.f, last1 = 0.f;
#pragma unroll
    for (int w = 0; w < 8; ++w) { const f32x2 t = *(LAS f32x2*)(TOT + w * 128 + 2 * lane); last0 += t.x; last1 += t.y;
        const bool before = rev ? (w > wid) : (w < wid); if (before) { off0 += t.x; off1 += t.y; }
        const bool inmid = rev ? (w >= 4) : (w < 4); if (inmid) { mid0 += t.x; mid1 += t.y; } }
    if (wid == 0) *(LAS f32x2*)(BL + 2 * lane) = (f32x2){last0, last1};
    ld0 += last0; ld1 += last1;
    unsigned kd0p[4], kd1p[4];
    {
        float kd0[8], kd1[8];
#pragma unroll
        for (int i = 0; i < 8; ++i) {
            const float b0 = off0 + c_0[i], b1 = off1 + c_1[i];
            const float k0 = kk0[i], k1 = kk1[i];
            kd0[i] = k0 * __expf(last0 - b0); kd1[i] = k1 * __expf(last1 - b1);
            if (OUT) {
                const float q0 = bf_lo(qv[i]), q1 = bf_hi(qv[i]); const int j = 8 * wid + i;
                *(LAS unsigned*)(lds + QE_OFF + (j * RS128 + 2 * lane) * 2) = cvt_pk_bf16(q0 * __expf(b0 - mid0), q1 * __expf(b1 - mid1));
                *(LAS unsigned*)(lds + KE_OFF + (j * RS128 + 2 * lane) * 2) = cvt_pk_bf16(k0 * __expf(mid0 - b0), k1 * __expf(mid1 - b1));
                *(LAS unsigned*)(lds + QD_OFF + (j * RS128 + 2 * lane) * 2) = cvt_pk_bf16(q0 * __expf(b0), q1 * __expf(b1));
            }
        }
#pragma unroll
        for (int k = 0; k < 4; ++k) { kd0p[k] = cvt_pk_bf16(kd0[2 * k], kd0[2 * k + 1]); kd1p[k] = cvt_pk_bf16(kd1[2 * k], kd1[2 * k + 1]); }
    }
    *(LAS u32x4*)(lds + KDT_OFF + ((2 * lane) * RS64 + 8 * wid) * 2) = (u32x4){kd0p[0], kd0p[1], kd0p[2], kd0p[3]};
    *(LAS u32x4*)(lds + KDT_OFF + ((2 * lane + 1) * RS64 + 8 * wid) * 2) = (u32x4){kd1p[0], kd1p[1], kd1p[2], kd1p[3]};
    {
        u32x4 a, b;
        a.x = (vv[0] & 0xffffu) | (vv[1] << 16); a.y = (vv[2] & 0xffffu) | (vv[3] << 16); a.z = (vv[4] & 0xffffu) | (vv[5] << 16); a.w = (vv[6] & 0xffffu) | (vv[7] << 16);
        b.x = (vv[0] >> 16) | (vv[1] & 0xffff0000u); b.y = (vv[2] >> 16) | (vv[3] & 0xffff0000u); b.z = (vv[4] >> 16) | (vv[5] & 0xffff0000u); b.w = (vv[6] >> 16) | (vv[7] & 0xffff0000u);
        *(LAS u32x4*)(lds + VT_OFF + ((2 * lane) * RS64 + 8 * wid) * 2) = a;
        *(LAS u32x4*)(lds + VT_OFF + ((2 * lane + 1) * RS64 + 8 * wid) * 2) = b;
    }
    if (has_next) scan_load<OUT>(F, N, Qg, Vg, nLFg, nrow0, nhcol);
    __syncthreads();
    __builtin_amdgcn_sched_barrier(0);
    if (OUT) {
        const int jt = wid >> 1;
#pragma unroll
        for (int x = 0; x < 2; ++x) {
            const int it = (wid & 1) * 2 + x; f32x4 a = {0.f, 0.f, 0.f, 0.f};
            const bool dead = rev ? (it < jt) : (it > jt);
            if (!dead) {
#pragma unroll
                for (int kt = 0; kt < 4; ++kt) { const bf16x8 P = *(const LAS bf16x8*)(lds + KE_OFF + ((it * 16 + r) * RS128 + kt * 32 + 8 * q) * 2), Qf = *(const LAS bf16x8*)(lds + QE_OFF + ((jt * 16 + r) * RS128 + kt * 32 + 8 * q) * 2);
                    a = mfma16(P, Qf, a); }
            }
            const int j = jt * 16 + r;
#pragma unroll
            for (int e = 0; e < 4; ++e) { const int i = it * 16 + 4 * q + e; const bool keep = rev ? (i >= j) : (i <= j); if (!keep) a[e] = 0.f; }
            *(LAS u32x2*)(lds + AL_OFF + (j * RS64 + it * 16 + 4 * q) * 2) = (u32x2){cvt_pk_bf16(a[0], a[1]), cvt_pk_bf16(a[2], a[3])};
            __builtin_amdgcn_sched_barrier(0);
        }
        __syncthreads();
    }
    bf16x8 Pvt[2];
#pragma unroll
    for (int kt = 0; kt < 2; ++kt) Pvt[kt] = *(const LAS bf16x8*)(lds + VT_OFF + ((16 * wid + r) * RS64 + kt * 32 + 8 * q) * 2);
    if (OUT) {
        bf16x8 Pst[4];
#pragma unroll
        for (int kt = 0; kt < 4; ++kt) Pst[kt] = *(const LAS bf16x8*)(lds + ST_OFF + ((16 * wid + r) * RS128 + kt * 32 + 8 * q) * 2);
#pragma unroll
        for (int jt2 = 0; jt2 < 4; ++jt2) {
            bf16x8 Qd[4], Qa[2];
#pragma unroll
            for (int kt = 0; kt < 4; ++kt) Qd[kt] = *(const LAS bf16x8*)(lds + QD_OFF + ((jt2 * 16 + r) * RS128 + kt * 32 + 8 * q) * 2);
#pragma unroll
            for (int kt = 0; kt < 2; ++kt) Qa[kt] = *(const LAS bf16x8*)(lds + AL_OFF + ((jt2 * 16 + r) * RS64 + kt * 32 + 8 * q) * 2);
            f32x4 o = oacc[jt2];
#pragma unroll
            for (int kt = 0; kt < 4; ++kt) o = mfma16(Pst[kt], Qd[kt], o);
#pragma unroll
            for (int kt = 0; kt < 2; ++kt) o = mfma16(Pvt[kt], Qa[kt], o);
            oacc[jt2] = o;
            if (jt2 == 1) __builtin_amdgcn_sched_barrier(0);
        }
    }
#pragma unroll
    for (int dt = 0; dt < 8; ++dt) {
        const f32x4 bl = *(const LAS f32x4*)(BL + 16 * dt + 4 * q);
        bf16x8 Pk[2];
#pragma unroll
        for (int kt = 0; kt < 2; ++kt) Pk[kt] = *(const LAS bf16x8*)(lds + KDT_OFF + ((16 * dt + r) * RS64 + kt * 32 + 8 * q) * 2);
        f32x4 s = Sacc[dt]; s[0] *= __expf(bl[0]); s[1] *= __expf(bl[1]); s[2] *= __expf(bl[2]); s[3] *= __expf(bl[3]);
#pragma unroll
        for (int kt = 0; kt < 2; ++kt) s = mfma16(Pk[kt], Pvt[kt], s);
        Sacc[dt] = s;
        if (OUT) *(LAS u32x2*)(lds + ST_OFF + ((16 * wid + r) * RS128 + 16 * dt + 4 * q) * 2) = (u32x2){cvt_pk_bf16(s[0], s[1]), cvt_pk_bf16(s[2], s[3])};
        if ((dt & 3) == 3) __builtin_amdgcn_sched_barrier(0);
    }
}

__device__ __forceinline__ void scan_pass1(const Frame& F) {
    const bf16_t* Vg = (const bf16_t*)(F.ws + WS_R + R_V); const _Float16* LF = (const _Float16*)(F.ws + WS_R + R_LF);
    bf16_t* DS = (bf16_t*)(F.ws + WS_R + R_DS); float* DEC = (float*)(F.ws + WS_R + R_DEC);
    const int wid = F.wid, lane = F.lane, r = lane & 15, q = lane >> 4;
    int item = F.bid, cc = 0;
    ScanPre pre, nxt;
    int chain = item >> 6, n = ((item & 63) + 7 * chain) & 63, dir = chain & 1, bh = chain >> 1, b = bh / 6, h = bh % 6, nch = n == 0 ? 4 : 2;
    int rowbase = n == 0 ? ML + b * 256 : b * 8192 + (dir ? 63 - (n - 1) : (n - 1)) * 128;
    if (item < 24 * 64) scan_load<false>(F, pre, nullptr, Vg, LF + (size_t)dir * MT * DH, rowbase + 64 * (dir ? nch - 1 : 0), h * 128);
    f32x4 Sacc[8], odum[4]; float ld0 = 0.f, ld1 = 0.f;
#pragma unroll 1
    while (item < 24 * 64) {
        int item2 = item, cc2 = cc + 1; if (cc2 == nch) { cc2 = 0; item2 = item + F.G; }
        const bool has_next = item2 < 24 * 64;
        const int chain2 = item2 >> 6, n2 = ((item2 & 63) + 7 * chain2) & 63, dir2 = chain2 & 1, bh2 = chain2 >> 1, b2 = bh2 / 6, h2 = bh2 % 6, nch2 = n2 == 0 ? 4 : 2;
        const int rowbase2 = n2 == 0 ? ML + b2 * 256 : b2 * 8192 + (dir2 ? 63 - (n2 - 1) : (n2 - 1)) * 128;
        const int c2 = dir2 ? nch2 - 1 - cc2 : cc2;
        if (cc == 0) {
#pragma unroll
            for (int i = 0; i < 8; ++i) Sacc[i] = (f32x4){0.f, 0.f, 0.f, 0.f};
            ld0 = 0.f; ld1 = 0.f;
        }
        scan_chunk<false>(F, pre, nxt, has_next, nullptr, Vg, LF + (size_t)dir2 * MT * DH, rowbase2 + 64 * c2, h2 * 128, dir != 0, Sacc, odum, ld0, ld1);
        if (cc == nch - 1) {
            const int sid = (item >> 6) * 64 + (((item & 63) + 7 * (item >> 6)) & 63);
            bf16_t* slot = DS + (size_t)sid * 16384;
#pragma unroll
            for (int dt = 0; dt < 8; ++dt) *(u32x2*)(slot + (16 * wid + r) * 128 + 16 * dt + 4 * q) = (u32x2){cvt_pk_bf16(Sacc[dt][0], Sacc[dt][1]), cvt_pk_bf16(Sacc[dt][2], Sacc[dt][3])};
            if (wid == 0) *(f32x2*)(DEC + (size_t)sid * 128 + 2 * lane) = (f32x2){__expf(ld0), __expf(ld1)};
        }
        pre = nxt; item = item2; cc = cc2; dir = dir2; nch = nch2;
    }
    __syncthreads();
}
__device__ __forceinline__ void scan_pass2(const Frame& F) {
    bf16_t* DS = (bf16_t*)(F.ws + WS_R + R_DS); const float* DEC = (const float*)(F.ws + WS_R + R_DEC);
    for (int idx = F.bid * NTHR + F.tid; idx < 24 * 4096; idx += F.G * NTHR) {
        const int chain = idx >> 12, e4 = (idx & 4095) * 4, d = e4 & 127;
        bf16_t* p = DS + (size_t)chain * 64 * 16384 + e4; const float* dc = DEC + (size_t)chain * 64 * 128 + d;
        const u32x2 w = *(const u32x2*)p; float t0 = bf_lo(w.x), t1 = bf_hi(w.x), t2 = bf_lo(w.y), t3 = bf_hi(w.y);
#pragma unroll 8
        for (int m = 1; m < 64; ++m) { const u32x2 x = *(const u32x2*)(p + (size_t)m * 16384); const f32x4 de = *(const f32x4*)(dc + m * 128);
            t0 = de[0] * t0 + bf_lo(x.x); t1 = de[1] * t1 + bf_hi(x.x); t2 = de[2] * t2 + bf_lo(x.y); t3 = de[3] * t3 + bf_hi(x.y);
            *(u32x2*)(p + (size_t)m * 16384) = (u32x2){cvt_pk_bf16(t0, t1), cvt_pk_bf16(t2, t3)}; }
    }
}
__device__ __forceinline__ void scan_pass3(const Frame& F, const float* hgrn_norm_g) {
    const bf16_t* Qg = (const bf16_t*)(F.ws + WS_R + R_Q); const bf16_t* Vg = (const bf16_t*)(F.ws + WS_R + R_V); const bf16_t* GT = (const bf16_t*)(F.ws + WS_R + R_GT);
    const _Float16* LF = (const _Float16*)(F.ws + WS_R + R_LF); const bf16_t* DS = (const bf16_t*)(F.ws + WS_R + R_DS); bf16_t* HM = (bf16_t*)(F.ws + WS_H);
    LAS unsigned char* lds = F.lds; LAS float* RED = (LAS float*)(lds + RED_OFF);
    const int wid = F.wid, lane = F.lane, r = lane & 15, q = lane >> 4;
    ScanPre pre, nxt;
    u32x2 Spre[8];
    if (F.bid < 12 * 64) { const int bh0 = F.bid >> 6, mp0 = F.bid & 63; scan_load<true>(F, pre, Qg, Vg, LF, (bh0 / 6) * 8192 + mp0 * 128, (bh0 % 6) * 128);
        const bf16_t* slot0 = DS + (size_t)((bh0 * 2) * 64 + mp0) * 16384;
#pragma unroll
        for (int dt = 0; dt < 8; ++dt) Spre[dt] = *(const u32x2*)(slot0 + (16 * wid + r) * 128 + 16 * dt + 4 * q); }
#pragma unroll 1
    for (int item = F.bid; item < 12 * 64; item += F.G) {
        const int bh = item >> 6, mphys = item & 63, b = bh / 6, h = bh % 6, rowbase = b * 8192 + mphys * 128;
        f32x4 oacc[2][4];
#pragma unroll
        for (int c = 0; c < 2; ++c)
#pragma unroll
            for (int j = 0; j < 4; ++j) oacc[c][j] = (f32x4){0.f, 0.f, 0.f, 0.f};
        float ld0 = 0.f, ld1 = 0.f;
        f32x4 Sacc[8];
#pragma unroll 1
        for (int k = 0; k < 4; ++k) {
            const int dir = k >> 1;
            const int k2 = (k + 1) & 3, item2 = k == 3 ? item + F.G : item; const bool has_next = item2 < 12 * 64;
            const int bh2 = item2 >> 6, mp2 = item2 & 63, dir2 = k2 >> 1, c2 = dir2 ? 1 - (k2 & 1) : (k2 & 1);
            const int nrow0 = (bh2 / 6) * 8192 + mp2 * 128 + 64 * c2, nhcol = (bh2 % 6) * 128;
            if ((k & 1) == 0) {
#pragma unroll
                for (int dt = 0; dt < 8; ++dt) { const u32x2 w = Spre[dt]; Sacc[dt] = (f32x4){bf_lo(w.x), bf_hi(w.x), bf_lo(w.y), bf_hi(w.y)};
                    *(LAS u32x2*)(lds + ST_OFF + ((16 * wid + r) * RS128 + 16 * dt + 4 * q) * 2) = w; }
            } else if (has_next) {
                const int chain2 = bh2 * 2 + dir2, m2 = dir2 ? 63 - mp2 : mp2;
                const bf16_t* slot2 = DS + (size_t)(chain2 * 64 + m2) * 16384;
#pragma unroll
                for (int dt = 0; dt < 8; ++dt) Spre[dt] = *(const u32x2*)(slot2 + (16 * wid + r) * 128 + 16 * dt + 4 * q);
            }
            scan_chunk<true>(F, pre, nxt, has_next, Qg, Vg, LF + (size_t)dir2 * MT * DH, nrow0, nhcol, dir != 0, Sacc, oacc[0], ld0, ld1);
            pre = nxt;
            if ((k & 1) == 0) {
#pragma unroll
                for (int j = 0; j < 4; ++j) { const f32x4 t = oacc[0][j]; oacc[0][j] = oacc[1][j]; oacc[1][j] = t; }
            }
        }
#pragma unroll
        for (int c = 0; c < 2; ++c)
#pragma unroll
            for (int j = 0; j < 4; ++j) { const f32x4 o = oacc[c][j]; float ss = o[0] * o[0] + o[1] * o[1] + o[2] * o[2] + o[3] * o[3]; ss += __shfl_xor(ss, 16); ss += __shfl_xor(ss, 32);
                if (q == 0) RED[(64 * c + 16 * j + r) * 8 + wid] = ss; }
        __syncthreads();
        const int col = h * 128 + 16 * wid + 4 * q; const f32x4 gn = *(const f32x4*)(hgrn_norm_g + col);
        u32x2 gtv[2][4];
#pragma unroll
        for (int c = 0; c < 2; ++c)
#pragma unroll
            for (int j = 0; j < 4; ++j) gtv[c][j] = *(const u32x2*)(GT + (size_t)(rowbase + 64 * c + 16 * j + r) * DH + col);
#pragma unroll
        for (int c = 0; c < 2; ++c)
#pragma unroll
            for (int j = 0; j < 4; ++j) { const int tok = 64 * c + 16 * j + r; const f32x4 s0 = *(const LAS f32x4*)(RED + tok * 8), s1 = *(const LAS f32x4*)(RED + tok * 8 + 4);
                const float ss = (s0[0] + s0[1]) + (s0[2] + s0[3]) + (s1[0] + s1[1]) + (s1[2] + s1[3]); const float rstd = 1.0f / sqrtf(ss * (1.0f / 128.0f) + EPS);
                const size_t row = (size_t)(rowbase + tok); const u32x2 gt = gtv[c][j]; const f32x4 o = oacc[c][j];
                const float y0 = o[0] * rstd * gn[0] * bf_lo(gt.x), y1 = o[1] * rstd * gn[1] * bf_hi(gt.x), y2 = o[2] * rstd * gn[2] * bf_lo(gt.y), y3 = o[3] * rstd * gn[3] * bf_hi(gt.y);
                *(u32x2*)(HM + row * D + 256 + col) = (u32x2){cvt_pk_bf16(y0, y1), cvt_pk_bf16(y2, y3)}; }
        __syncthreads();
    }
}

__device__ __forceinline__ void pool_phase(const Frame& F, const float* pool_w, const float* pool_scale) {
    const float* PP = (const float*)(F.ws + WS_R + R_PP); bf16_t* HM = (bf16_t*)(F.ws + WS_H);
    LAS float* PL = (LAS float*)F.lds; LAS float* YL = (LAS float*)(F.lds + 65536);
    const int tid = F.tid;
    for (int item = F.bid; item < 256; item += F.G) {
        const int rowbase = item * 64;
        __syncthreads();
#pragma unroll
        for (int i = 0; i < 8; ++i) { const int e = (tid + NTHR * i) * 4, t = e >> 8, ch = e & 255; *(LAS f32x4*)(PL + t * 256 + ch) = *(const f32x4*)(PP + (size_t)(rowbase + t) * 256 + ch); }
        __syncthreads();
#pragma unroll
        for (int i = 0; i < 8; ++i) { const int e = (tid + NTHR * i) * 4, t = e >> 8, ch = e & 255, g = ch >> 6, w = 2 << g; int lo = t - (w >> 1), hi = lo + w; lo = lo < 0 ? 0 : lo; hi = hi > 64 ? 64 : hi;
            f32x4 s = {0.f, 0.f, 0.f, 0.f};
            for (int p = lo; p < hi; ++p) s += *(const LAS f32x4*)(PL + p * 256 + ch);
            const float inv = 1.0f / (float)(hi - lo);
            *(LAS f32x4*)(YL + t * 260 + ch) = s * inv - *(const LAS f32x4*)(PL + t * 256 + ch); }
        __syncthreads();
        {
            const int g = tid >> 7, tq = (tid >> 3) & 15, dq = tid & 7;
            f32x4 a[4][2];
#pragma unroll
            for (int k = 0; k < 4; ++k) { a[k][0] = (f32x4){0.f, 0.f, 0.f, 0.f}; a[k][1] = a[k][0]; }
            const float* wp = pool_w + (size_t)g * 4096 + dq * 8;
#pragma unroll 4
            for (int c = 0; c < 64; ++c) { const f32x4 w0 = *(const f32x4*)(wp + c * 64), w1 = *(const f32x4*)(wp + c * 64 + 4);
#pragma unroll
                for (int k = 0; k < 4; ++k) { const float y = YL[(tq + 16 * k) * 260 + g * 64 + c]; a[k][0] += w0 * y; a[k][1] += w1 * y; } }
            const f32x4 s0 = *(const f32x4*)(pool_scale + g * 64 + dq * 8), s1 = *(const f32x4*)(pool_scale + g * 64 + dq * 8 + 4);
#pragma unroll
            for (int k = 0; k < 4; ++k) { const f32x4 x0 = a[k][0] * s0, x1 = a[k][1] * s1;
                u32x4 w; w.x = cvt_pk_bf16(x0[0], x0[1]); w.y = cvt_pk_bf16(x0[2], x0[3]); w.z = cvt_pk_bf16(x1[0], x1[1]); w.w = cvt_pk_bf16(x1[2], x1[3]);
                *(u32x4*)(HM + (size_t)(rowbase + tq + 16 * k) * D + g * 64 + dq * 8) = w; }
        }
    }
    __syncthreads();
}

__device__ __forceinline__ void gmlp_phase(const Frame& F, const float* ln_g, const float* ln_b, const float* b_s) {
    const bf16_t* U = (const bf16_t*)(F.ws + WS_R + R_U); const bf16_t* VG = (const bf16_t*)(F.ws + WS_R + R_VG); const bf16_t* WSB = (const bf16_t*)(F.ws + WS_WS); bf16_t* HM = (bf16_t*)(F.ws + WS_H);
    LAS unsigned char* lds = F.lds; constexpr int VNT_OFF = 0, WSL_OFF = 34816, STAT_OFF = 69632;
    LAS float* STAT = (LAS float*)(lds + STAT_OFF);
    const int tid = F.tid, wid = F.wid, lane = F.lane, r = lane & 15, q = lane >> 4;
    for (int item = F.bid; item < 256; item += F.G) {
        const int n = item >> 1, gh = item & 1, rowbase = n * 128;
        __syncthreads();
#pragma unroll 1
        for (int i0 = 0; i0 < 16; i0 += 4) {
            u32x4 ra[4], rb[4];
#pragma unroll
            for (int t = 0; t < 4; ++t) { const bf16_t* p = VG + (size_t)(rowbase + 16 * wid + i0 + t) * D + lane * 16; ra[t] = *(const u32x4*)p; rb[t] = *(const u32x4*)(p + 8); }
#pragma unroll
            for (int t = 0; t < 4; ++t) { const int tk = 16 * wid + i0 + t; float s = 0.f, ss = 0.f;
                const unsigned ws8[8] = {ra[t].x, ra[t].y, ra[t].z, ra[t].w, rb[t].x, rb[t].y, rb[t].z, rb[t].w};
#pragma unroll
                for (int k = 0; k < 8; ++k) { const float lo = bf_lo(ws8[k]), hi = bf_hi(ws8[k]); s += lo + hi; ss += lo * lo + hi * hi; }
#pragma unroll
                for (int o = 32; o >= 1; o >>= 1) { s += __shfl_xor(s, o); ss += __shfl_xor(ss, o); }
                const float mean = s * (1.0f / D); float var = ss * (1.0f / D) - mean * mean; var = var < 0.f ? 0.f : var;
                if (lane == 0) *(LAS f32x2*)(STAT + tk * 2) = (f32x2){mean, 1.0f / sqrtf(var + EPS)}; }
        }
        __syncthreads();
        u32x4 wsr[4]; unsigned xr[16];
        {
            const int g0 = gh * 4;
#pragma unroll
            for (int i = 0; i < 4; ++i) { const int id = tid + NTHR * i, p = id >> 4, q8 = (id & 15) * 8; wsr[i] = *(const u32x4*)(WSB + (size_t)g0 * 16384 + p * 128 + q8); }
#pragma unroll
            for (int i = 0; i < 16; ++i) xr[i] = *(const unsigned*)(VG + (size_t)(rowbase + 16 * wid + i) * D + g0 * 128 + 2 * lane);
        }
#pragma unroll 1
        for (int gi = 0; gi < 4; ++gi) {
            const int g = gh * 4 + gi;
#pragma unroll
            for (int i = 0; i < 4; ++i) { const int id = tid + NTHR * i, p = id >> 4, q8 = (id & 15) * 8; *(LAS u32x4*)(lds + WSL_OFF + (p * RS128 + q8) * 2) = wsr[i]; }
            {
                const int c0 = g * 128 + 2 * lane; const f32x2 lg = *(const f32x2*)(ln_g + c0), lb2 = *(const f32x2*)(ln_b + c0);
                unsigned lo8[8], hi8[8]; float pl = 0.f, ph = 0.f;
#pragma unroll
                for (int i = 0; i < 16; ++i) { const int tk = 16 * wid + i; const unsigned x = xr[i]; const f32x2 st = *(const LAS f32x2*)(STAT + tk * 2);
                    const float y0 = (bf_lo(x) - st.x) * st.y * lg.x + lb2.x, y1 = (bf_hi(x) - st.x) * st.y * lg.y + lb2.y;
                    if (i & 1) { lo8[i >> 1] = cvt_pk_bf16(pl, y0); hi8[i >> 1] = cvt_pk_bf16(ph, y1); } else { pl = y0; ph = y1; } }
                *(LAS u32x4*)(lds + VNT_OFF + ((2 * lane) * RS128 + 16 * wid) * 2) = (u32x4){lo8[0], lo8[1], lo8[2], lo8[3]}; *(LAS u32x4*)(lds + VNT_OFF + ((2 * lane) * RS128 + 16 * wid + 8) * 2) = (u32x4){lo8[4], lo8[5], lo8[6], lo8[7]};
                *(LAS u32x4*)(lds + VNT_OFF + ((2 * lane + 1) * RS128 + 16 * wid) * 2) = (u32x4){hi8[0], hi8[1], hi8[2], hi8[3]}; *(LAS u32x4*)(lds + VNT_OFF + ((2 * lane + 1) * RS128 + 16 * wid + 8) * 2) = (u32x4){hi8[4], hi8[5], hi8[6], hi8[7]};
            }
            if (gi < 3) {
                const int g1 = g + 1;
#pragma unroll
                for (int i = 0; i < 4; ++i) { const int id = tid + NTHR * i, p = id >> 4, q8 = (id & 15) * 8; wsr[i] = *(const u32x4*)(WSB + (size_t)g1 * 16384 + p * 128 + q8); }
#pragma unroll
                for (int i = 0; i < 16; ++i) xr[i] = *(const unsigned*)(VG + (size_t)(rowbase + 16 * wid + i) * D + g1 * 128 + 2 * lane);
            }
            __syncthreads();
            f32x4 acc[8];
#pragma unroll
            for (int ct = 0; ct < 8; ++ct) acc[ct] = (f32x4){0.f, 0.f, 0.f, 0.f};
#pragma unroll
            for (int kt = 0; kt < 4; ++kt) { const bf16x8 Qf = *(const LAS bf16x8*)(lds + WSL_OFF + ((16 * wid + r) * RS128 + kt * 32 + 8 * q) * 2);
#pragma unroll
                for (int ct = 0; ct < 8; ++ct) { const bf16x8 P = *(const LAS bf16x8*)(lds + VNT_OFF + ((16 * ct + r) * RS128 + kt * 32 + 8 * q) * 2); acc[ct] = mfma16(P, Qf, acc[ct]); } __builtin_amdgcn_sched_barrier(0); }
            const int tk = 16 * wid + r; const float bs = b_s[g * 128 + tk]; const size_t rowo = (size_t)(rowbase + tk) * D + g * 128 + 4 * q;
            u32x2 uu[8];
#pragma unroll
            for (int ct = 0; ct < 8; ++ct) uu[ct] = *(const u32x2*)(U + rowo + 16 * ct);
#pragma unroll
            for (int ct = 0; ct < 8; ++ct) { const u32x2 u2 = uu[ct]; const f32x4 a = acc[ct];
                *(u32x2*)(HM + rowo + 16 * ct) = (u32x2){cvt_pk_bf16(bf_lo(u2.x) * (a[0] + bs), bf_hi(u2.x) * (a[1] + bs)), cvt_pk_bf16(bf_lo(u2.y) * (a[2] + bs), bf_hi(u2.y) * (a[3] + bs))}; }
            __syncthreads();
        }
    }
}

#define XB_TMO      128
#define XB_XCNT(j)  (256  + 64 * (j))
#define XB_XSUB(j)  (1280 + 64 * (j))
#define XB_XGEN(j)  (2304 + 64 * (j))
#define XB_TOP      3328
#define XB_TOPGEN   3392
#define XCD_BAR_WORDS 3456
#define XB_SPIN_CAP (1u << 18)

__device__ __forceinline__ unsigned xb_ld(unsigned* p)              { return __hip_atomic_load(p, __ATOMIC_RELAXED, __HIP_MEMORY_SCOPE_AGENT); }
__device__ __forceinline__ unsigned xb_add(unsigned* p, unsigned v) { return __hip_atomic_fetch_add(p, v, __ATOMIC_RELAXED, __HIP_MEMORY_SCOPE_AGENT); }
__device__ __forceinline__ unsigned xb_xcc_id() { return (unsigned)__builtin_amdgcn_s_getreg((3 << 11) | 20) & 0xFu; }
#define XB_SPIN(cond, bar) do { unsigned _sp = 0; while (cond) { __builtin_amdgcn_s_sleep(1); \
    if ((++_sp & 255u) == 0u) { if (xb_ld(&(bar)[XB_TMO])) break; if (_sp > XB_SPIN_CAP) { atomicAdd(&(bar)[XB_TMO], 1u); break; } } } } while (0)

struct XcdBarrier {
    unsigned* bar; unsigned x;
    volatile LAS unsigned* st;
};

__device__ __forceinline__ XcdBarrier xcd_barrier_post(unsigned* bar, volatile LAS unsigned* st) {
    XcdBarrier b; b.bar = bar; b.x = xb_xcc_id(); b.st = st;
    if (threadIdx.x == 0) (void)xb_add(&bar[XB_XCNT(b.x)], 1u);
    return b;
}
__device__ __forceinline__ void xcd_barrier_complete(unsigned* bar, unsigned x, unsigned& nloc, unsigned& nx) {
    const unsigned G = gridDim.x * gridDim.y * gridDim.z;
    unsigned sum, cnt, mine, sp = 0u;
    for (;;) {
        sum = 0u; cnt = 0u; mine = 0u;
#pragma unroll
        for (unsigned j = 0; j < 16; ++j) { const unsigned c = xb_ld(&bar[XB_XCNT(j)]); sum += c; cnt += (c > 0u) ? 1u : 0u; mine = (j == x) ? c : mine; }
        if (sum == G) break;
        __builtin_amdgcn_s_sleep(1);
        if ((++sp & 255u) == 0u) { if (xb_ld(&bar[XB_TMO])) break; if (sp > XB_SPIN_CAP) { atomicAdd(&bar[XB_TMO], 1u); break; } }
    }
    nloc = mine > 0u ? mine : 1u; nx = cnt > 0u ? cnt : 1u;
}

__device__ __forceinline__ void xcd_barrier(const XcdBarrier& b) {
    asm volatile("s_waitcnt vmcnt(0)" ::: "memory");
    __syncthreads();
    if (threadIdx.x == 0) {
        unsigned* bar = b.bar;
        __builtin_amdgcn_s_waitcnt(0);
        unsigned nloc = b.st[0], nx = b.st[1];
        if (nloc == 0u) { xcd_barrier_complete(bar, b.x, nloc, nx); b.st[0] = nloc; b.st[1] = nx; }
        const unsigned old = xb_add(&bar[XB_XSUB(b.x)], 1u);
        const unsigned gen = old / nloc;
        if (old + 1u == (gen + 1u) * nloc) {
            __builtin_amdgcn_fence(__ATOMIC_RELEASE, "agent");
            asm volatile("s_waitcnt vmcnt(0)" ::: "memory");
            const unsigned og = xb_add(&bar[XB_TOP], 1u);
            const unsigned tg = og / nx;
            if (og + 1u == (tg + 1u) * nx) xb_add(&bar[XB_TOPGEN], 1u);
            else XB_SPIN(xb_ld(&bar[XB_TOPGEN]) == tg, bar);
            __builtin_amdgcn_fence(__ATOMIC_ACQUIRE, "agent");
            xb_add(&bar[XB_XGEN(b.x)], 1u);
            asm volatile("s_waitcnt vmcnt(0)" ::: "memory");
        } else {
            XB_SPIN(xb_ld(&bar[XB_XGEN(b.x)]) == gen, bar);
            __builtin_amdgcn_fence(__ATOMIC_ACQUIRE, "agent");
            asm volatile("s_waitcnt vmcnt(0)" ::: "memory");
        }
    }
    __syncthreads();
}

__global__ void __launch_bounds__(NTHR) mega_fwd(Args args) {
    extern __shared__ __attribute__((aligned(16))) unsigned char lds_raw[];
    cg::grid_group grid = cg::this_grid();
    Frame F;
    F.lds = (LAS unsigned char*)lds_raw; F.tid = threadIdx.x; F.lane = F.tid & 63; F.wid = __builtin_amdgcn_readfirstlane(F.tid >> 6); F.G = gridDim.x; F.bid = blockIdx.x;
    F.out = args.out; F.ws = args.ws;
    unsigned char* ws = F.ws;
    float* XL = F.out; float* XC = (float*)(ws + WS_XC); bf16_t* H = (bf16_t*)(ws + WS_H); bf16_t* G = (bf16_t*)(ws + WS_R + R_G);
    const float* MOD0 = (const float*)(ws + WS_MOD); const float* MOD1 = MOD0 + 3 * NMODD;
    const int lo = args.ph_lo, hi = args.ph_hi;
    if (lo < -1) grid.sync();
    volatile LAS unsigned* bst = (volatile LAS unsigned*)(F.lds + LDS_BYTES - 16);
    if (F.tid < 4) bst[F.tid] = 0u;
    __syncthreads();
    const XcdBarrier xbar = xcd_barrier_post((unsigned*)(ws + WS_BAR), bst);
#define IN(k) (lo <= (k) && (k) < hi)
#ifndef PROBE_MASK
#define PROBE_MASK 0u
#endif
#ifndef PROBE_SCALE
#define PROBE_SCALE 1.0f
#endif
    unsigned long long* TS = (unsigned long long*)(ws + 2048);
    const bool stamper = PROBE_MASK != 0u && F.bid == 0 && F.tid == 0;
    if (stamper) TS[0] = __builtin_amdgcn_s_memrealtime();
#define SEAM(k) do { if (IN(k) && IN((k) + 1)) { xcd_barrier(xbar); } if (stamper) TS[(k) + 1] = __builtin_amdgcn_s_memrealtime(); } while (0)
    if (IN(0)) mod_phase(F, args.in[1], args.in[3], args.in[4], args.in[5], args.in[19]); SEAM(0);
    if (IN(1)) { norm_phase(F, args.in[0], args.in[2], MT, args.in[6] + 0 * D, MOD0, 0, H); run_tjobs(F, args, 0, 0x53u, 0, F.G); } SEAM(1);
    if (IN(2)) run_gemm(F, H, (const bf16_t*)(ws + WS_UP0), MT, 2 * DFF, D, EpiSwiGlu{G}); SEAM(2);
    if (IN(3)) { run_gemm(F, G, (const bf16_t*)(ws + WS_DN0), ML, D, DFF, EpiResid{args.in[0], args.in[2], XL, XC, MOD0 + 2 * 1024, 0.5f});
        run_ctx_down_splitk(F, G + (size_t)ML * DFF, (const bf16_t*)(ws + WS_DN0), (float*)(ws + WS_R + R_PART)); } SEAM(3);
    if (IN(4)) norm_phase(F, XL, args.in[2], MT, args.in[6] + 1 * D, MOD0, 1, H, (const float*)(ws + WS_R + R_PART), MOD0 + 2 * NMODD + 2 * 1024); SEAM(4);
    if (IN(5)) { run_gemm(F, H, (const bf16_t*)(ws + WS_WIN), MT, DIN, D, EpiWin{ws + WS_R, args.in[13]}); run_tjobs(F, args, 0, 0x3ACu, 32, F.G - 32); } SEAM(5);
    if (IN(6)) scan_pass1(F); SEAM(6);
    if (IN(7)) { scan_pass2(F); pool_phase(F, args.in[11], args.in[12]); } SEAM(7);
    if (IN(8)) scan_pass3(F, args.in[14]); SEAM(8);
    if (IN(9)) run_gemm(F, H, (const bf16_t*)(ws + WS_WOUT), ML, D, D, EpiResid{XL, XC, XL, XC, MOD0 + 5 * 1024, 1.0f}); SEAM(9);
    if (IN(10)) norm_phase(F, XL, XC, ML, args.in[6] + 2 * D, MOD0, 2, H); SEAM(10);
    if (IN(11)) { run_gemm(F, H, (const bf16_t*)(ws + WS_UP0 + SZ_UP), ML, 2 * DFF, D, EpiSwiGlu{G}); run_tjobs(F, args, 1, 0x13u, 128, F.G - 128); } SEAM(11);
    if (IN(12)) run_gemm(F, G, (const bf16_t*)(ws + WS_DN0 + SZ_DN), ML, D, DFF, EpiResid{XL, XC, XL, XC, MOD0 + 8 * 1024, 0.5f}); SEAM(12);
    if (IN(13)) norm_phase(F, XL, XC, ML, args.in[6] + 3 * D, MOD1, 0, H); SEAM(13);
    if (IN(14)) { run_gemm(F, H, (const bf16_t*)(ws + WS_R + R_UP1), ML, 2 * DFF, D, EpiSwiGlu{G}); run_tjobs(F, args, 1, 0x2Cu, 128, F.G - 128); } SEAM(14);
    if (IN(15)) run_gemm(F, G, (const bf16_t*)(ws + WS_R + R_DN1), ML, D, DFF, EpiResid{XL, XC, XL, XC, MOD1 + 2 * 1024, 0.5f}); SEAM(15);
    if (IN(16)) norm_phase(F, XL, XC, ML, args.in[6] + 4 * D, MOD1, 1, H); SEAM(16);
    if (IN(17)) run_gemm(F, H, (const bf16_t*)(ws + WS_GIN), ML, 2 * D, D, EpiGin{(bf16_t*)(ws + WS_R + R_U), (bf16_t*)(ws + WS_R + R_VG)}); SEAM(17);
    if (IN(18)) gmlp_phase(F, args.in[17], args.in[18], args.in[20]); SEAM(18);
    if (IN(19)) run_gemm(F, H, (const bf16_t*)(ws + WS_GOUT), ML, D, D, EpiResid{XL, XC, XL, XC, MOD1 + 5 * 1024, 1.0f}); SEAM(19);
    if (IN(20)) norm_phase(F, XL, XC, ML, args.in[6] + 5 * D, MOD1, 2, H); SEAM(20);
    if (IN(21)) run_gemm(F, H, (const bf16_t*)(ws + WS_R + R_UP1 + SZ_UP), ML, 2 * DFF, D, EpiSwiGlu{G}); SEAM(21);
    if (IN(22)) run_gemm(F, G, (const bf16_t*)(ws + WS_R + R_DN1 + SZ_DN), ML, D, DFF, EpiResid{XL, XC, XL, XC, MOD1 + 8 * 1024, 0.5f}); SEAM(22);
    if (IN(23)) final_norm_phase(F, XL, args.in[22]);
    if (PROBE_MASK != 0u && F.bid == 0) { __syncthreads(); if (F.tid == 0) { TS[24] = __builtin_amdgcn_s_memrealtime(); unsigned long long tot = 0;
        for (int k = 0; k < 24; ++k) if ((PROBE_MASK >> k) & 1u) tot += TS[k + 1] - TS[k];
        F.out[0] = (float)tot * 1e-5f * PROBE_SCALE; } }
}
constexpr int NPHASES = 24;
#ifndef MK_PER_PHASE
#define MK_PER_PHASE 0
#endif

extern "C" void kernel_launch(void* const* d_in, const int* in_sizes, int n_in, void* d_out, int out_size, void* d_ws, size_t ws_size, hipStream_t stream) {
    static int grid = 0;
    if (grid == 0) {
        if (n_in != 23 || out_size != ML * D || ws_size < WS_END) { fprintf(stderr, "kernel_launch: unexpected shapes (n_in %d out %d ws %zu need %zu)\n", n_in, out_size, ws_size, (size_t)WS_END); grid = -1; return; }
        int dev = 0, cus = 0, per_cu = 0;
        hipGetDevice(&dev); hipDeviceGetAttribute(&cus, hipDeviceAttributeMultiprocessorCount, dev);
        hipFuncSetAttribute((const void*)mega_fwd, hipFuncAttributeMaxDynamicSharedMemorySize, LDS_BYTES);
        hipOccupancyMaxActiveBlocksPerMultiprocessor(&per_cu, (const void*)mega_fwd, NTHR, LDS_BYTES);
        if (per_cu < 1) { fprintf(stderr, "kernel_launch: occupancy query says %d blocks per CU\n", per_cu); per_cu = 1; }
        (void)hipGetLastError();
        grid = cus;
    }
    if (grid < 0) return;
    if (hipMemsetAsync((unsigned char*)d_ws + WS_BAR, 0, XCD_BAR_WORDS * 4, stream) != hipSuccess) { fprintf(stderr, "kernel_launch: memset failed\n"); return; }
    Args a{};
    for (int i = 0; i < 23; ++i) a.in[i] = (const float*)d_in[i];
    a.out = (float*)d_out; a.ws = (unsigned char*)d_ws;
#if MK_PER_PHASE
    for (int p = 0; p < NPHASES; ++p) { a.ph_lo = p; a.ph_hi = p + 1; hipLaunchKernelGGL(mega_fwd, dim3(grid), dim3(NTHR), LDS_BYTES, stream, a); }
#else
    a.ph_lo = 0; a.ph_hi = NPHASES;
    void* kargs[] = {&a};
    hipError_t e = hipLaunchCooperativeKernel((const void*)mega_fwd, dim3(grid), dim3(NTHR), kargs, LDS_BYTES, stream);
    if (e != hipSuccess) fprintf(stderr, "kernel_launch: cooperative launch failed: %s (grid %d)\n", hipGetErrorString(e), grid);
#endif
}
```

```cpp
#include <hip/hip_runtime.h>
#include <hip/hip_cooperative_groups.h>
#include <cstdio>
namespace cg = cooperative_groups;
namespace pg8 {
#define PG8_LAS __attribute__((address_space(3)))
typedef unsigned short bf16_t;
typedef short bf16x8 __attribute__((ext_vector_type(8)));
typedef float f32x4 __attribute__((ext_vector_type(4)));
typedef unsigned u32x4 __attribute__((ext_vector_type(4)));
constexpr int BM = 256, BK = 64, HALF = 128, HTB = HALF * BK * 2  , STAGE_BYTES = 8 * HTB, NXCD = 8, WGM = 8;

__host__ __device__ __forceinline__ int lds_byte(int r, int c) { const int st = (r >> 4) * 2 + (c >> 5), rr = r & 15, cc = c & 31, ob = rr * 64 + cc * 2; return st * 1024 + (ob ^ (((ob >> 9) & 1) << 5)); }
__host__ __device__ __forceinline__ void stage_rc(int b, int& R, int& C) { const int st = b / 1024, sb = b % 1024, swz = sb ^ (((sb >> 9) & 1) << 5); R = (st >> 1) * 16 + swz / 64; C = (st & 1) * 32 + (swz % 64) / 2; }
__host__ __device__ __forceinline__ int perm32(int rho) { const int n = rho >> 4, i = rho & 15; return 8 * (i >> 2) + 4 * n + (i & 3); }

struct Unit { int pm, pn; };
struct Gemm { const bf16_t* A; const bf16_t* Bt; int M, N, K, ld; };

struct StaticOrder {
    int nM, nN, nwg, G, c;
    __host__ __device__ void init(int M, int N, int G_, int c_) { nM = M / BM; nN = N / BM; nwg = nM * nN; G = G_; c = c_; }
    __host__ __device__ bool next(int i, Unit& u) const {
        const long L = (long)i * G + c; if (L >= nwg) return false;
        int wgid = (int)L; { const int q = nwg / NXCD, r = nwg % NXCD, xcd = wgid % NXCD, off = wgid / NXCD; wgid = (xcd < r ? xcd * (q + 1) : r * (q + 1) + (xcd - r) * q) + off; }
        const int nig = WGM * nN, gid = wgid / nig, fm = gid * WGM, gsz = (nM - fm) < WGM ? (nM - fm) : WGM;
        u.pm = fm + ((wgid % nig) % gsz); u.pn = (wgid % nig) / gsz; return true;
    }
    __device__ __forceinline__ void a_ready(const Unit&) const {}
    __device__ __forceinline__ void done(const Unit&) const {}
};
typedef __bf16 bf16v2_t __attribute__((ext_vector_type(2)));
typedef float f32v2_t __attribute__((ext_vector_type(2)));
__device__ __forceinline__ unsigned cvt_pk_bf16(float lo, float hi) { const f32v2_t v = {lo, hi}; const bf16v2_t b = __builtin_convertvector(v, bf16v2_t); return __builtin_bit_cast(unsigned, b); }
template <class Epi, class Sched, bool STAMP = false>
__device__ __forceinline__ void gemm_phase(PG8_LAS unsigned char* lds, const Gemm g, const Sched& S, const Epi& E, unsigned long long* stamps) {
    const int tid = threadIdx.x, wid = __builtin_amdgcn_readfirstlane(tid >> 6), lane = tid & 63, wr = wid >> 2, wc = wid & 3, fr = lane & 15, fq = lane >> 4;
    const int K = g.K, nt = K / BK, ld = g.ld;
    int ts_lo = 0, ts_hi = 0, nts = 0; const unsigned long long rt_entry = STAMP ? (unsigned long long)wall_clock64() : 0ull;
#define PG8_STAMP() do { if (STAMP && wid == 0 && nts < 64) { const unsigned long long _c = (unsigned long long)clock64(); \
        ts_lo = (lane == nts) ? (int)(unsigned)_c : ts_lo; ts_hi = (lane == nts) ? (int)(unsigned)(_c >> 32) : ts_hi; ++nts; } } while (0)
    PG8_STAMP();
    unsigned voffA[2], voffB[2];
#pragma unroll
    for (int i = 0; i < 2; ++i) { int R, C; stage_rc(tid * 16 + i * 8192, R, C); const int Rb = Epi::PERM ? ((R & ~31) + perm32(R & 31)) : R;
        voffA[i] = (unsigned)(R * ld + C) * 2u; voffB[i] = (unsigned)(Rb * ld + C) * 2u; }
    const size_t kstep = (size_t)(BK * 2);
    const size_t hstep = (size_t)HALF * ld * 2;
    const size_t tstep = 2 * hstep;
    const unsigned ldsw = (unsigned)wid * 1024u;
    const int aoff = lds_byte(wr * 64 + fr, fq * 8), boff = lds_byte(wc * 32 + fr, fq * 8);
#define PG8_SA(b, h) (((b) * 2 + (h)) * HTB)
#define PG8_SB(b, h) ((4 + (b) * 2 + (h)) * HTB)
#define PG8_STAGE(bufoff, gbase, voff) do { _Pragma("unroll") for (int _i = 0; _i < 2; ++_i) \
        __builtin_amdgcn_global_load_lds((const unsigned*)((const char*)(gbase) + (voff)[_i]), (PG8_LAS unsigned*)(lds + (bufoff) + ldsw + _i * 8192), 16, 0, 0); } while (0)
#define PG8_LDA(dst, b, h) do { _Pragma("unroll") for (int m = 0; m < 4; ++m) _Pragma("unroll") for (int k = 0; k < 2; ++k) dst[m][k] = *(const PG8_LAS bf16x8*)(lds + PG8_SA(b, h) + aoff + m * 2048 + k * 1024); } while (0)
#define PG8_LDB(dst, b, h) do { _Pragma("unroll") for (int n = 0; n < 2; ++n) _Pragma("unroll") for (int k = 0; k < 2; ++k) dst[n][k] = *(const PG8_LAS bf16x8*)(lds + PG8_SB(b, h) + boff + n * 2048 + k * 1024); } while (0)
#define PG8_MMA(ai, bj, At, Bt) do { __builtin_amdgcn_s_setprio(1); _Pragma("unroll") for (int m = 0; m < 4; ++m) _Pragma("unroll") for (int n = 0; n < 2; ++n) _Pragma("unroll") for (int k = 0; k < 2; ++k) \
        acc[ai][bj][m][n] = __builtin_amdgcn_mfma_f32_16x16x32_bf16(Bt[n][k], At[m][k], acc[ai][bj][m][n], 0, 0, 0); __builtin_amdgcn_s_setprio(0); } while (0)
#define PG8_WAIT_V(n) asm volatile("s_waitcnt vmcnt(" #n ")" ::: "memory")
#define PG8_WAIT_L(n) asm volatile("s_waitcnt lgkmcnt(" #n ")" ::: "memory")
#define PG8_BAR __builtin_amdgcn_s_barrier()
#define PG8_SCHED __builtin_amdgcn_sched_barrier(0)
    Unit cur, nxt; int ui = 0;
    if (!S.next(0, cur)) return;
    f32x4 acc[2][2][4][2];
#pragma unroll
    for (int a = 0; a < 2; ++a)
#pragma unroll
        for (int b = 0; b < 2; ++b)
#pragma unroll
            for (int m = 0; m < 4; ++m)
#pragma unroll
                for (int n = 0; n < 2; ++n) acc[a][b][m][n] = (f32x4){0.f, 0.f, 0.f, 0.f};
    bf16x8 At[4][2], B0[2][2], B1[2][2];
    const char* cA = (const char*)g.A + (size_t)cur.pm * tstep; const char* cB = (const char*)g.Bt + (size_t)cur.pn * tstep;
    S.a_ready(cur);
    PG8_STAGE(PG8_SB(0, 0), cB, voffB); PG8_STAGE(PG8_SA(0, 0), cA, voffA); PG8_STAGE(PG8_SB(0, 1), cB + hstep, voffB); PG8_STAGE(PG8_SA(0, 1), cA + hstep, voffA);
    if (wr == 1) PG8_BAR;
    PG8_WAIT_V(4); PG8_BAR;
    PG8_STAGE(PG8_SB(1, 0), cB + kstep, voffB); PG8_STAGE(PG8_SA(1, 0), cA + kstep, voffA); PG8_STAGE(PG8_SB(1, 1), cB + hstep + kstep, voffB);
    PG8_WAIT_V(6); PG8_BAR;
    PG8_STAMP();
    for (;;) {
        const bool has_next = S.next(ui + 1, nxt);
        const char* nA = has_next ? (const char*)g.A + (size_t)nxt.pm * tstep : cA; const char* nB = has_next ? (const char*)g.Bt + (size_t)nxt.pn * tstep : cB;
        for (int t = 0; t < nt; t += 2) {
            const bool last = (t == nt - 2);
            const char* a1 = cA + (size_t)(t + 1) * kstep;
            const char* a2 = last ? nA : cA + (size_t)(t + 2) * kstep; const char* b2 = last ? nB : cB + (size_t)(t + 2) * kstep;
            const char* a3 = a2 + kstep; const char* b3 = b2 + kstep;
            if (last && has_next) S.a_ready(nxt);
            PG8_LDB(B0, 0, 0); PG8_SCHED; PG8_LDA(At, 0, 0); PG8_STAGE(PG8_SA(1, 1), a1 + hstep, voffA);
            PG8_WAIT_L(8); PG8_BAR; PG8_WAIT_L(0); PG8_MMA(0, 0, At, B0); PG8_BAR; PG8_SCHED;
            PG8_LDB(B1, 0, 1); PG8_STAGE(PG8_SB(0, 0), b2, voffB);
            PG8_BAR; PG8_WAIT_L(0); PG8_MMA(0, 1, At, B1); PG8_BAR;
            PG8_LDA(At, 0, 1); PG8_STAGE(PG8_SA(0, 0), a2, voffA);
            PG8_BAR; PG8_WAIT_L(0); PG8_MMA(1, 0, At, B0); PG8_BAR; PG8_SCHED;
            PG8_STAGE(PG8_SB(0, 1), b2 + hstep, voffB);
            PG8_WAIT_V(6); PG8_BAR; PG8_MMA(1, 1, At, B1); PG8_BAR;
            PG8_LDB(B0, 1, 0); PG8_SCHED; PG8_LDA(At, 1, 0); PG8_STAGE(PG8_SA(0, 1), a2 + hstep, voffA);
            PG8_WAIT_L(8); PG8_BAR; PG8_WAIT_L(0); PG8_MMA(0, 0, At, B0); PG8_BAR; PG8_SCHED;
            PG8_LDB(B1, 1, 1); PG8_STAGE(PG8_SB(1, 0), b3, voffB);
            PG8_BAR; PG8_WAIT_L(0); PG8_MMA(0, 1, At, B1); PG8_BAR;
            PG8_LDA(At, 1, 1); PG8_STAGE(PG8_SA(1, 0), a3, voffA);
            PG8_BAR; PG8_WAIT_L(0); PG8_MMA(1, 0, At, B0); PG8_BAR; PG8_SCHED;
            PG8_STAGE(PG8_SB(1, 1), b3 + hstep, voffB);
            PG8_WAIT_V(6); PG8_BAR; PG8_MMA(1, 1, At, B1); PG8_BAR;
        }
        PG8_STAMP();
        if constexpr (!Epi::AFTER_DRAIN) { E(acc, cur, wr, wc, fr, fq); S.done(cur); }
        PG8_STAMP();
        if (!has_next) break;
#pragma unroll
        for (int a = 0; a < 2; ++a)
#pragma unroll
            for (int b = 0; b < 2; ++b)
#pragma unroll
                for (int m = 0; m < 4; ++m)
#pragma unroll
                    for (int n = 0; n < 2; ++n) acc[a][b][m][n] = (f32x4){0.f, 0.f, 0.f, 0.f};
        cur = nxt; cA = nA; cB = nB; ++ui;
    }
    PG8_WAIT_V(0);
    if (wr == 0) PG8_BAR;
    PG8_BAR;
    if constexpr (Epi::AFTER_DRAIN) { E.fused(acc, cur, wr, wc, fr, fq, lds, wid, lane); S.done(cur); }
    PG8_STAMP();
    if (STAMP && wid == 0) { stamps[lane] = lane < nts ? (((unsigned long long)(unsigned)ts_hi << 32) | (unsigned)ts_lo) : 0ull;
        if (lane == 62) stamps[62] = rt_entry; if (lane == 63) stamps[63] = (unsigned long long)wall_clock64(); }
#undef PG8_STAMP
#undef PG8_SA
#undef PG8_SB
#undef PG8_STAGE
#undef PG8_LDA
#undef PG8_LDB
#undef PG8_MMA
#undef PG8_WAIT_V
#undef PG8_WAIT_L
#undef PG8_BAR
#undef PG8_SCHED
}
}

using pg8::bf16_t; using pg8::bf16x8; using pg8::f32x4; using pg8::u32x4; using pg8::Unit; using pg8::cvt_pk_bf16;
#define LAS __attribute__((address_space(3)))
typedef float f32x2 __attribute__((ext_vector_type(2)));
typedef unsigned u32x2 __attribute__((ext_vector_type(2)));
typedef _Float16 f16x2 __attribute__((ext_vector_type(2)));
typedef _Float16 f16x8 __attribute__((ext_vector_type(8)));

constexpr int D = 1024, ML = 16384, MC = 512, MT = ML + MC, DFF = 2816, DH = 768, DIN = 4096, NMODD = 9 * 1024;
constexpr float EPS = 1e-6f;
constexpr int NTHR = 512;
constexpr int LDS_BYTES = 147456;

constexpr size_t al256(size_t x) { return (x + 255) & ~(size_t)255; }
constexpr size_t WS_BAR   = 4096;
constexpr size_t WS_MOD   = 4096 + 16384;
constexpr size_t WS_XC    = al256(WS_MOD + (size_t)2 * 3 * NMODD * 4);
constexpr size_t SZ_UP    = (size_t)2 * DFF * D * 2;
constexpr size_t SZ_DN    = (size_t)D * DFF * 2;
constexpr size_t WS_UP0   = al256(WS_XC + (size_t)MC * D * 4);
constexpr size_t WS_DN0   = WS_UP0 + 2 * SZ_UP;
constexpr size_t WS_WIN   = WS_DN0 + 2 * SZ_DN;
constexpr size_t WS_WOUT  = WS_WIN + (size_t)DIN * D * 2;
constexpr size_t WS_GIN   = WS_WOUT + (size_t)D * D * 2;
constexpr size_t WS_GOUT  = WS_GIN + (size_t)2 * D * D * 2;
constexpr size_t WS_WS    = WS_GOUT + (size_t)D * D * 2;
constexpr size_t WS_H     = al256(WS_WS + (size_t)8 * 128 * 128 * 2);
constexpr size_t WS_R     = al256(WS_H + (size_t)MT * D * 2);
constexpr size_t R_G      = 0;
constexpr size_t R_UP1    = al256((size_t)MT * DFF * 2 + 4096);
constexpr size_t R_DN1    = R_UP1 + 2 * SZ_UP;
constexpr size_t R_FFN_END = R_DN1 + 2 * SZ_DN;
constexpr size_t R_PART   = R_UP1;
constexpr size_t R_PP     = 0;
constexpr size_t R_Q      = al256(R_PP + (size_t)MT * 256 * 4);
constexpr size_t R_V      = al256(R_Q + (size_t)MT * DH * 2);
constexpr size_t R_GT     = al256(R_V + (size_t)MT * DH * 2);
constexpr size_t R_LF     = al256(R_GT + (size_t)MT * DH * 2);
constexpr size_t R_DS     = al256(R_LF + (size_t)2 * MT * DH * 2);
constexpr size_t R_DEC    = al256(R_DS + (size_t)1536 * 16384 * 2);
constexpr size_t R_AB_END = al256(R_DEC + (size_t)1536 * 128 * 4);
constexpr size_t R_U      = 0;
constexpr size_t R_VG     = (size_t)ML * D * 2;
constexpr size_t R_SIZE   = R_AB_END > R_FFN_END ? R_AB_END : R_FFN_END;
constexpr size_t WS_END   = WS_R + R_SIZE;

struct Args {
    const float* in[23]; float* out; unsigned char* ws; int ph_lo, ph_hi;
};

struct Frame {
    LAS unsigned char* lds; int tid, lane, wid, G, bid;
    float* out; unsigned char* ws;
};

__device__ __forceinline__ float bf_lo(unsigned w) { return __uint_as_float(w << 16); }
__device__ __forceinline__ float bf_hi(unsigned w) { return __uint_as_float(w & 0xffff0000u); }
__device__ __forceinline__ float fast_rcp(float x) { return __builtin_amdgcn_rcpf(x); }
__device__ __forceinline__ float sigmoidf_(float x) { return fast_rcp(1.0f + __expf(-x)); }
__device__ __forceinline__ float siluf_(float x) { return x * sigmoidf_(x); }
__device__ __forceinline__ float gelu_tanh(float x) { const float u = 0.7978845608f * (x + 0.044715f * x * x * x); return x * sigmoidf_(2.0f * u); }
__device__ __forceinline__ f32x4 mfma16(bf16x8 a, bf16x8 b, f32x4 c) { return __builtin_amdgcn_mfma_f32_16x16x32_bf16(a, b, c, 0, 0, 0); }

struct EpiSwiGlu {
    static constexpr bool PERM = true, AFTER_DRAIN = false;
    bf16_t* G;
    __device__ __forceinline__ void operator()(const f32x4 (&acc)[2][2][4][2], const Unit& u, int wr, int wc, int fr, int fq) const {
        const int row0 = u.pm * 256 + wr * 64 + fr, col0 = u.pn * 128 + wc * 32 + 8 * fq;
#pragma unroll
        for (int ai = 0; ai < 2; ++ai)
#pragma unroll
            for (int m = 0; m < 4; ++m) {
                bf16_t* p = G + (size_t)(row0 + ai * 128 + m * 16) * DFF + col0;
                const f32x4 a0 = acc[ai][0][m][0], a1 = acc[ai][0][m][1], b0 = acc[ai][1][m][0], b1 = acc[ai][1][m][1];
                u32x4 w;
                w.x = cvt_pk_bf16(siluf_(a0[0]) * b0[0], siluf_(a0[1]) * b0[1]); w.y = cvt_pk_bf16(siluf_(a0[2]) * b0[2], siluf_(a0[3]) * b0[3]);
                w.z = cvt_pk_bf16(siluf_(a1[0]) * b1[0], siluf_(a1[1]) * b1[1]); w.w = cvt_pk_bf16(siluf_(a1[2]) * b1[2], siluf_(a1[3]) * b1[3]);
                *(u32x4*)p = w;
            }
    }
};
struct EpiResid {
    static constexpr bool PERM = false, AFTER_DRAIN = false;
    const float* baseL; const float* baseC; float* outL; float* outC; const float* gate  ; float scale;
    __device__ __forceinline__ void operator()(const f32x4 (&acc)[2][2][4][2], const Unit& u, int wr, int wc, int fr, int fq) const {
        const bool isc = u.pm >= 64; const int vec = isc ? 2 : (u.pm >> 5);
        const int row0 = (isc ? (u.pm - 64) * 256 : u.pm * 256) + wr * 64 + fr, col0 = u.pn * 256 + wc * 32 + 4 * fq;
        const float* base = isc ? baseC : baseL; float* out = isc ? outC : outL;
        f32x4 gv[4];
#pragma unroll
        for (int g = 0; g < 4; ++g) gv[g] = *(const f32x4*)(gate + (size_t)vec * NMODD + col0 + (g >> 1) * 128 + (g & 1) * 16) * scale;
        f32x4 A[4], B[4];
#pragma unroll
        for (int m = 0; m < 4; ++m) A[m] = *(const f32x4*)(base + (size_t)(row0 + m * 16) * D + col0);
#pragma unroll
        for (int step = 0; step < 8; ++step) {
            const int g = step >> 1, hh = step & 1, bj = g >> 1, n = g & 1, cg = col0 + bj * 128 + n * 16;
            if (step < 7) { const int s2 = step + 1, g2 = s2 >> 1, h2 = s2 & 1, cn = col0 + (g2 >> 1) * 128 + (g2 & 1) * 16;
#pragma unroll
                for (int m = 0; m < 4; ++m) { const f32x4 t = *(const f32x4*)(base + (size_t)(row0 + h2 * 128 + m * 16) * D + cn); if (step & 1) A[m] = t; else B[m] = t; } }
            __builtin_amdgcn_sched_barrier(0);
#pragma unroll
            for (int m = 0; m < 4; ++m) *(f32x4*)(out + (size_t)(row0 + hh * 128 + m * 16) * D + cg) = ((step & 1) ? B[m] : A[m]) + gv[g] * acc[hh][bj][m][n];
            __builtin_amdgcn_sched_barrier(0);
        }
    }
};
struct EpiWin {
    static constexpr bool PERM = true, AFTER_DRAIN = false;
    unsigned char* R  ; const float* lb  ;
    __device__ __forceinline__ void operator()(const f32x4 (&acc)[2][2][4][2], const Unit& u, int wr, int wc, int fr, int fq) const {
        const int row0 = u.pm * 256 + wr * 64 + fr, cw = wc * 32 + 8 * fq;
        const int pn = u.pn;
        if (pn == 0) {
#pragma unroll
            for (int ai = 0; ai < 2; ++ai)
#pragma unroll
                for (int m = 0; m < 4; ++m) { float* p = (float*)(R + R_PP) + (size_t)(row0 + ai * 128 + m * 16) * 256 + cw;
#pragma unroll
                    for (int bj = 0; bj < 2; ++bj) { *(f32x4*)(p + bj * 128) = acc[ai][bj][m][0]; *(f32x4*)(p + bj * 128 + 4) = acc[ai][bj][m][1]; } }
            return;
        }
        const int sec = (pn - 1) / 3, scol = ((pn - 1) % 3) * 256 + cw;
        if (sec == 2 || sec == 3) {
            const int dir = sec - 2; _Float16* O = (_Float16*)(R + R_LF) + (size_t)dir * MT * DH;
#pragma unroll
            for (int bj = 0; bj < 2; ++bj) {
                float lbv[8];
#pragma unroll
                for (int e = 0; e < 8; ++e) { const int c = scol + bj * 128 + e; const float l0 = lb[dir * DH + c], l1 = lb[2 * DH + dir * DH + c]; lbv[e] = fast_rcp(1.0f + __expf(l1 - l0)); }
#pragma unroll
                for (int ai = 0; ai < 2; ++ai)
#pragma unroll
                    for (int m = 0; m < 4; ++m) { _Float16* p = O + (size_t)(row0 + ai * 128 + m * 16) * DH + scol; f16x8 w;
#pragma unroll
                        for (int e = 0; e < 8; ++e) { const float a = acc[ai][bj][m][e >> 2][e & 3]; const float l = lbv[e]; w[e] = (_Float16)fminf((1.0f - l) * fast_rcp(1.0f + __expf(a)), 0.9995f); }
                        *(f16x8*)(p + bj * 128) = w; }
                __builtin_amdgcn_sched_barrier(0);
            }
            return;
        }
        const size_t ooff = sec == 0 ? R_Q : (sec == 1 ? R_V : R_GT); bf16_t* O = (bf16_t*)(R + ooff);
#pragma unroll
        for (int ai = 0; ai < 2; ++ai)
#pragma unroll
            for (int m = 0; m < 4; ++m) { bf16_t* p = O + (size_t)(row0 + ai * 128 + m * 16) * DH + scol;
#pragma unroll
                for (int bj = 0; bj < 2; ++bj) { float v[8];
#pragma unroll
                    for (int e = 0; e < 8; ++e) { const float a = acc[ai][bj][m][e >> 2][e & 3]; v[e] = sec == 0 ? siluf_(a) * 0.08838834764831845f : (sec == 1 ? a : siluf_(a)); }
                    u32x4 w; w.x = cvt_pk_bf16(v[0], v[1]); w.y = cvt_pk_bf16(v[2], v[3]); w.z = cvt_pk_bf16(v[4], v[5]); w.w = cvt_pk_bf16(v[6], v[7]);
                    *(u32x4*)(p + bj * 128) = w; } }
    }
};
struct EpiGin {
    static constexpr bool PERM = true, AFTER_DRAIN = false;
    bf16_t* U; bf16_t* VG;
    __device__ __forceinline__ void operator()(const f32x4 (&acc)[2][2][4][2], const Unit& u, int wr, int wc, int fr, int fq) const {
        const int row0 = u.pm * 256 + wr * 64 + fr; bf16_t* O = u.pn < 4 ? U : VG; const int col0 = (u.pn & 3) * 256 + wc * 32 + 8 * fq;
#pragma unroll
        for (int ai = 0; ai < 2; ++ai)
#pragma unroll
            for (int m = 0; m < 4; ++m) { bf16_t* p = O + (size_t)(row0 + ai * 128 + m * 16) * D + col0;
#pragma unroll
                for (int bj = 0; bj < 2; ++bj) { const f32x4 a0 = acc[ai][bj][m][0], a1 = acc[ai][bj][m][1]; u32x4 w;
                    w.x = cvt_pk_bf16(gelu_tanh(a0[0]), gelu_tanh(a0[1])); w.y = cvt_pk_bf16(gelu_tanh(a0[2]), gelu_tanh(a0[3]));
                    w.z = cvt_pk_bf16(gelu_tanh(a1[0]), gelu_tanh(a1[1])); w.w = cvt_pk_bf16(gelu_tanh(a1[2]), gelu_tanh(a1[3]));
                    *(u32x4*)(p + bj * 128) = w; } }
    }
};

template <class Epi>
__device__ __forceinline__ void run_gemm(const Frame& F, const bf16_t* A, const bf16_t* Bt, int M, int N, int K, const Epi& E) {
    pg8::StaticOrder S; S.init(M, N, F.G, F.bid);
    pg8::Gemm g; g.A = A; g.Bt = Bt; g.M = M; g.N = N; g.K = K; g.ld = K;
    pg8::gemm_phase<Epi, pg8::StaticOrder, false>(F.lds, g, S, E, nullptr);
    __syncthreads();
}

struct OneUnit {
    int pm, pn; bool on;
    __device__ bool next(int i, Unit& u) const { if (i != 0 || !on) return false; u.pm = pm; u.pn = pn; return true; }
    __device__ __forceinline__ void a_ready(const Unit&) const {}
    __device__ __forceinline__ void done(const Unit&) const {}
};
struct EpiPartCtx {
    static constexpr bool PERM = false, AFTER_DRAIN = false;
    float* part;
    __device__ __forceinline__ void operator()(const f32x4 (&acc)[2][2][4][2], const Unit& u, int wr, int wc, int fr, int fq) const {
        const int row0 = u.pm * 256 + wr * 64 + fr, col0 = u.pn * 256 + wc * 32 + 4 * fq;
#pragma unroll
        for (int ai = 0; ai < 2; ++ai)
#pragma unroll
            for (int m = 0; m < 4; ++m) { float* p = part + (size_t)(row0 + ai * 128 + m * 16) * D + col0;
#pragma unroll
                for (int bj = 0; bj < 2; ++bj)
#pragma unroll
                    for (int n = 0; n < 2; ++n) *(f32x4*)(p + bj * 128 + n * 16) = acc[ai][bj][m][n]; }
    }
};
__device__ __forceinline__ void run_ctx_down_splitk(const Frame& F, const bf16_t* Gctx  , const bf16_t* Bt, float* part) {
    const int ks = F.bid % 11, tile = F.bid / 11;
    OneUnit S; S.on = F.bid < 88; S.pm = tile >> 2; S.pn = tile & 3;
    pg8::Gemm g; g.A = Gctx + ks * 256; g.Bt = Bt + ks * 256; g.M = MC; g.N = D; g.K = 256; g.ld = DFF;
    EpiPartCtx E; E.part = part + (size_t)ks * MC * D;
    pg8::gemm_phase<EpiPartCtx, OneUnit, false>(F.lds, g, S, E, nullptr);
    __syncthreads();
}

__device__ __forceinline__ void transpose_tile(const Frame& F, const float* W, bf16_t* Bt, int K, int N, int mode, int tile) {
    LAS float* T = (LAS float*)F.lds;
    const int ntn = N >> 8, tk = tile / ntn, tn = tile % ntn, k0 = tk * 64, n0 = tn * 256;
    const int tid = F.tid;
    __syncthreads();
    f32x4 v[8];
#pragma unroll
    for (int i = 0; i < 8; ++i) { const int id = tid + NTHR * i, r = id >> 6, c4 = (id & 63) * 4; v[i] = *(const f32x4*)(W + (size_t)(k0 + r) * N + n0 + c4); }
#pragma unroll
    for (int i = 0; i < 8; ++i) { const int id = tid + NTHR * i, r = id >> 6, c4 = (id & 63) * 4; LAS float* p = T + r * 257 + c4; p[0] = v[i][0]; p[1] = v[i][1]; p[2] = v[i][2]; p[3] = v[i][3]; }
    __syncthreads();
#pragma unroll
    for (int j = 0; j < 4; ++j) { const int id = tid + NTHR * j, nl = id >> 3, k8 = (id & 7) * 8;
        const float v0 = T[(k8 + 0) * 257 + nl], v1 = T[(k8 + 1) * 257 + nl], v2 = T[(k8 + 2) * 257 + nl], v3 = T[(k8 + 3) * 257 + nl], v4 = T[(k8 + 4) * 257 + nl], v5 = T[(k8 + 5) * 257 + nl], v6 = T[(k8 + 6) * 257 + nl], v7 = T[(k8 + 7) * 257 + nl];
        const int n = n0 + nl; const int row = mode == 0 ? n : ((n >> 7) * 256 + (n & 127) + (mode == 2 ? 128 : 0));
        u32x4 w; w.x = cvt_pk_bf16(v0, v1); w.y = cvt_pk_bf16(v2, v3); w.z = cvt_pk_bf16(v4, v5); w.w = cvt_pk_bf16(v6, v7);
        *(u32x4*)(Bt + (size_t)row * K + k0 + k8) = w; }
}
__device__ __forceinline__ void do_tjob(const Frame& F, const Args& A, int set, int i, int tile) {
    const int layer = set;
    unsigned char* upb = set == 0 ? F.ws + WS_UP0 : F.ws + WS_R + R_UP1; unsigned char* dnb = set == 0 ? F.ws + WS_DN0 : F.ws + WS_R + R_DN1;
    const float* W; bf16_t* Bt; int K, N, mode;
    if (i < 4) { const int f = i >> 1, which = i & 1; W = (which ? A.in[8] : A.in[7]) + (size_t)(layer * 2 + f) * D * DFF; Bt = (bf16_t*)(upb + (size_t)f * SZ_UP); K = D; N = DFF; mode = 1 + which; }
    else if (i < 6) { const int f = i - 4; W = A.in[9] + (size_t)(layer * 2 + f) * DFF * D; Bt = (bf16_t*)(dnb + (size_t)f * SZ_DN); K = DFF; N = D; mode = 0; }
    else if (i == 6) { W = A.in[10]; Bt = (bf16_t*)(F.ws + WS_WIN); K = D; N = DIN; mode = 0; }
    else if (i == 7) { W = A.in[15]; Bt = (bf16_t*)(F.ws + WS_WOUT); K = D; N = D; mode = 0; }
    else if (i == 8) { W = A.in[16]; Bt = (bf16_t*)(F.ws + WS_GIN); K = D; N = 2 * D; mode = 0; }
    else { W = A.in[21]; Bt = (bf16_t*)(F.ws + WS_GOUT); K = D; N = D; mode = 0; }
    transpose_tile(F, W, Bt, K, N, mode, tile);
}
__device__ __forceinline__ int tjob_tiles(int i) { return i < 6 ? 176 : (i == 6 ? 256 : (i == 8 ? 128 : 64)); }
__device__ __forceinline__ void run_tjobs(const Frame& F, const Args& A, int set, unsigned jobmask, int first_wg, int n_wgs) {
    const int nj = set == 0 ? 10 : 6;
    if (F.bid >= first_wg && F.bid < first_wg + n_wgs) {
        int total = 0;
        for (int i = 0; i < nj; ++i) if ((jobmask >> i) & 1u) total += tjob_tiles(i);
        for (int t = F.bid - first_wg; t < total; t += n_wgs) {
            int rem = t, ji = 0; bool found = false;
            for (int i = 0; i < nj; ++i) if (((jobmask >> i) & 1u) && !found) { const int cnt = tjob_tiles(i); if (rem < cnt) { ji = i; found = true; } else rem -= cnt; }
            do_tjob(F, A, set, ji, rem);
        }
    }
    __syncthreads();
}


__device__ __forceinline__ void mod_phase(const Frame& F, const float* c_in, const float* c_ctx, const float* mod_w, const float* mod_b, const float* w_s) {
    LAS float* SC = (LAS float*)F.lds;
    LAS float* RED = (LAS float*)(F.lds + 3 * 1024 * 4);
    const int tid = F.tid;
    __syncthreads();
    for (int i = tid; i < 3 * 1024; i += NTHR) { const int v = i >> 10, k = i & 1023; const float c = v < 2 ? c_in[v * 1024 + k] : c_ctx[k]; SC[i] = siluf_(c); }
    __syncthreads();
    float* MOD = (float*)(F.ws + WS_MOD);
    const int cg4 = tid & 7, ks = tid >> 3;
    for (int item = F.bid; item < 2 * 288; item += F.G) {
        const int l = item / 288, n0 = (item % 288) * 32;
        const float* W = mod_w + (size_t)l * D * NMODD + n0 + cg4 * 4;
        f32x4 a0 = {0.f, 0.f, 0.f, 0.f}, a1 = a0, a2 = a0;
#pragma unroll 8
        for (int r = 0; r < 16; ++r) { const int k = ks * 16 + r; const f32x4 w = *(const f32x4*)(W + (size_t)k * NMODD); a0 += w * SC[k]; a1 += w * SC[1024 + k]; a2 += w * SC[2048 + k]; }
        __syncthreads();
        *(LAS f32x4*)(RED + (ks * 3 + 0) * 32 + cg4 * 4) = a0; *(LAS f32x4*)(RED + (ks * 3 + 1) * 32 + cg4 * 4) = a1; *(LAS f32x4*)(RED + (ks * 3 + 2) * 32 + cg4 * 4) = a2;
        __syncthreads();
        if (tid < 96) { const int v = tid >> 5, c = tid & 31; float s = 0.f;
            for (int k2 = 0; k2 < 64; ++k2) s += RED[(k2 * 3 + v) * 32 + c];
            MOD[(size_t)(l * 3 + v) * NMODD + n0 + c] = s + mod_b[(size_t)l * NMODD + n0 + c]; }
    }
    __syncthreads();
    bf16_t* WSB = (bf16_t*)(F.ws + WS_WS);
    for (int i = (F.bid * NTHR + tid) * 2; i < 8 * 128 * 128; i += F.G * NTHR * 2) { const f32x2 v = *(const f32x2*)(w_s + i); *(unsigned*)(WSB + i) = cvt_pk_bf16(v.x, v.y); }
}

__device__ __forceinline__ void norm_phase(const Frame& F, const float* xl, const float* xc, int nrows, const float* g, const float* modl, int s, bf16_t* H, const float* part = nullptr, const float* pgate = nullptr) {
    const int lane = F.lane, stride = F.G * 8;
    for (int row0 = F.bid * 8 + F.wid; row0 < nrows; row0 += 2 * stride) {
        f32x4 v[2][4]; float ss[2];
#pragma unroll
        for (int t = 0; t < 2; ++t) { const int row = row0 + t * stride; const bool ok = row < nrows; const int rr = ok ? row : row0;
            const float* src = rr < ML ? xl + (size_t)rr * D : xc + (size_t)(rr - ML) * D;
#pragma unroll
            for (int i = 0; i < 4; ++i) v[t][i] = *(const f32x4*)(src + i * 256 + lane * 4);
            if (part != nullptr && rr >= ML) {
#pragma unroll
                for (int i = 0; i < 4; ++i) { f32x4 a = {0.f, 0.f, 0.f, 0.f};
#pragma unroll
                    for (int ks = 0; ks < 11; ++ks) a += *(const f32x4*)(part + ((size_t)ks * MC + (rr - ML)) * D + i * 256 + lane * 4);
                    v[t][i] += a * (*(const f32x4*)(pgate + i * 256 + lane * 4) * 0.5f); } }
        }
#pragma unroll
        for (int t = 0; t < 2; ++t) { float q = 0.f;
#pragma unroll
            for (int i = 0; i < 4; ++i) q += v[t][i][0] * v[t][i][0] + v[t][i][1] * v[t][i][1] + v[t][i][2] * v[t][i][2] + v[t][i][3] * v[t][i][3];
#pragma unroll
            for (int o = 32; o >= 1; o >>= 1) q += __shfl_xor(q, o);
            ss[t] = q; }
#pragma unroll
        for (int t = 0; t < 2; ++t) { const int row = row0 + t * stride; if (row < nrows) {
            const int vec = row < 8192 ? 0 : (row < ML ? 1 : 2);
            const float rstd = 1.0f / sqrtf(ss[t] * (1.0f / D) + EPS);
            const float* sc = modl + (size_t)vec * NMODD + (3 * s + 1) * 1024; const float* sh = modl + (size_t)vec * NMODD + (3 * s) * 1024;
            f32x4 gg[4], s4[4], h4[4];
#pragma unroll
            for (int i = 0; i < 4; ++i) { const int c = i * 256 + lane * 4; gg[i] = *(const f32x4*)(g + c); s4[i] = *(const f32x4*)(sc + c); h4[i] = *(const f32x4*)(sh + c); }
#pragma unroll
            for (int i = 0; i < 4; ++i) { const int c = i * 256 + lane * 4;
                const f32x4 y = (v[t][i] * rstd) * gg[i] * (s4[i] + 1.0f) + h4[i]; u32x2 w; w.x = cvt_pk_bf16(y[0], y[1]); w.y = cvt_pk_bf16(y[2], y[3]); *(u32x2*)(H + (size_t)row * D + c) = w; } } }
    }
}
__device__ __forceinline__ void final_norm_phase(const Frame& F, float* x, const float* g) {
    const int lane = F.lane, stride = F.G * 8;
    f32x4 gg[4];
#pragma unroll
    for (int i = 0; i < 4; ++i) gg[i] = *(const f32x4*)(g + i * 256 + lane * 4);
    for (int row0 = F.bid * 8 + F.wid; row0 < ML; row0 += 2 * stride) {
        f32x4 v[2][4];
#pragma unroll
        for (int t = 0; t < 2; ++t) { const int row = row0 + t * stride; const int rr = row < ML ? row : row0;
#pragma unroll
            for (int i = 0; i < 4; ++i) v[t][i] = *(const f32x4*)(x + (size_t)rr * D + i * 256 + lane * 4); }
#pragma unroll
        for (int t = 0; t < 2; ++t) { const int row = row0 + t * stride; float q = 0.f;
#pragma unroll
            for (int i = 0; i < 4; ++i) q += v[t][i][0] * v[t][i][0] + v[t][i][1] * v[t][i][1] + v[t][i][2] * v[t][i][2] + v[t][i][3] * v[t][i][3];
#pragma unroll
            for (int o = 32; o >= 1; o >>= 1) q += __shfl_xor(q, o);
            const float rstd = 1.0f / sqrtf(q * (1.0f / D) + EPS);
            if (row < ML) {
#pragma unroll
                for (int i = 0; i < 4; ++i) { const int c = i * 256 + lane * 4; *(f32x4*)(x + (size_t)row * D + c) = (v[t][i] * rstd) * gg[i]; } } }
    }
}

constexpr int RS128 = 136, RS64 = 72;
constexpr int QE_OFF = 0, KE_OFF = 17408, QD_OFF = 34816, KDT_OFF = 52224, VT_OFF = 70656, AL_OFF = 89088, ST_OFF = 98304, TOT_OFF = 133120, BL_OFF = 137216, RED_OFF = 137728;

struct ScanPre { unsigned lf[8], v[8], q[8]; };
template <bool OUT>
__device__ __forceinline__ void scan_load(const Frame& F, ScanPre& P, const bf16_t* Qg, const bf16_t* Vg, const _Float16* LFg, int row0, int hcol) {
    const int c0 = hcol + 2 * F.lane;
#pragma unroll
    for (int i = 0; i < 8; ++i) { const size_t ro = (size_t)(row0 + 8 * F.wid + i) * DH + c0; P.lf[i] = *(const unsigned*)(LFg + ro); P.v[i] = *(const unsigned*)(Vg + ro); P.q[i] = OUT ? *(const unsigned*)(Qg + ro) : 0u; }
}
template <bool OUT>
__device__ __forceinline__ void scan_chunk(const Frame& F, const ScanPre& P, ScanPre& N, bool has_next, const bf16_t* Qg, const bf16_t* Vg, const _Float16* nLFg, int nrow0, int nhcol, bool rev, f32x4 (&Sacc)[8], f32x4 (&oacc)[4], float& ld0, float& ld1) {
    LAS unsigned char* lds = F.lds; const int wid = F.wid, lane = F.lane, r = lane & 15, q = lane >> 4;
    LAS float* TOT = (LAS float*)(lds + TOT_OFF); LAS float* BL = (LAS float*)(lds + BL_OFF);
    float c_0[8], c_1[8], lf0[8], lf1[8]; unsigned qv[8], vv[8];
    float kk0[8], kk1[8];
#pragma unroll
    for (int i = 0; i < 8; ++i) { const f16x2 h = __builtin_bit_cast(f16x2, P.lf[i]); kk0[i] = (float)h.x; kk1[i] = (float)h.y; lf0[i] = __logf(1.0f - kk0[i]); lf1[i] = __logf(1.0f - kk1[i]); vv[i] = P.v[i]; qv[i] = P.q[i]; }
    float t0 = 0.f, t1 = 0.f;
    if (!rev) {
#pragma unroll
        for (int i = 0; i < 8; ++i) { t0 += lf0[i]; t1 += lf1[i]; c_0[i] = t0; c_1[i] = t1; }
    } else {
#pragma unroll
        for (int i = 7; i >= 0; --i) { t0 += lf0[i]; t1 += lf1[i]; c_0[i] = t0; c_1[i] = t1; }
    }
    *(LAS f32x2*)(TOT + wid * 128 + 2 * lane) = (f32x2){t0, t1};
    __syncthreads();
    __builtin_amdgcn_sched_barrier(0);
    float off0 = 0.f, off1 = 0.f, mid0 = 0.f, mid1 = 0.f, last0 = 0.f, last1 = 0.f;
#pragma unroll
    for (int w = 0; w < 8; ++w) { const f32x2 t = *(LAS f32x2*)(TOT + w * 128 + 2 * lane); last0 += t.x; last1 += t.y;
        const bool before = rev ? (w > wid) : (w < wid); if (before) { off0 += t.x; off1 += t.y; }
        const bool inmid = rev ? (w >= 4) : (w < 4); if (inmid) { mid0 += t.x; mid1 += t.y; } }
    if (wid == 0) *(LAS f32x2*)(BL + 2 * lane) = (f32x2){last0, last1};
    ld0 += last0; ld1 += last1;
    unsigned kd0p[4], kd1p[4];
    {
        float kd0[8], kd1[8];
#pragma unroll
        for (int i = 0; i < 8; ++i) {
            const float b0 = off0 + c_0[i], b1 = off1 + c_1[i];
            const float k0 = kk0[i], k1 = kk1[i];
            kd0[i] = k0 * __expf(last0 - b0); kd1[i] = k1 * __expf(last1 - b1);
            if (OUT) {
                const float q0 = bf_lo(qv[i]), q1 = bf_hi(qv[i]); const int j = 8 * wid + i;
                *(LAS unsigned*)(lds + QE_OFF + (j * RS128 + 2 * lane) * 2) = cvt_pk_bf16(q0 * __expf(b0 - mid0), q1 * __expf(b1 - mid1));
                *(LAS unsigned*)(lds + KE_OFF + (j * RS128 + 2 * lane) * 2) = cvt_pk_bf16(k0 * __expf(mid0 - b0), k1 * __expf(mid1 - b1));
                *(LAS unsigned*)(lds + QD_OFF + (j * RS128 + 2 * lane) * 2) = cvt_pk_bf16(q0 * __expf(b0), q1 * __expf(b1));
            }
        }
#pragma unroll
        for (int k = 0; k < 4; ++k) { kd0p[k] = cvt_pk_bf16(kd0[2 * k], kd0[2 * k + 1]); kd1p[k] = cvt_pk_bf16(kd1[2 * k], kd1[2 * k + 1]); }
    }
    *(LAS u32x4*)(lds + KDT_OFF + ((2 * lane) * RS64 + 8 * wid) * 2) = (u32x4){kd0p[0], kd0p[1], kd0p[2], kd0p[3]};
    *(LAS u32x4*)(lds + KDT_OFF + ((2 * lane + 1) * RS64 + 8 * wid) * 2) = (u32x4){kd1p[0], kd1p[1], kd1p[2], kd1p[3]};
    {
        u32x4 a, b;
        a.x = (vv[0] & 0xffffu) | (vv[1] << 16); a.y = (vv[2] & 0xffffu) | (vv[3] << 16); a.z = (vv[4] & 0xffffu) | (vv[5] << 16); a.w = (vv[6] & 0xffffu) | (vv[7] << 16);
        b.x = (vv[0] >> 16) | (vv[1] & 0xffff0000u); b.y = (vv[2] >> 16) | (vv[3] & 0xffff0000u); b.z = (vv[4] >> 16) | (vv[5] & 0xffff0000u); b.w = (vv[6] >> 16) | (vv[7] & 0xffff0000u);
        *(LAS u32x4*)(lds + VT_OFF + ((2 * lane) * RS64 + 8 * wid) * 2) = a;
        *(LAS u32x4*)(lds + VT_OFF + ((2 * lane + 1) * RS64 + 8 * wid) * 2) = b;
    }
    if (has_next) scan_load<OUT>(F, N, Qg, Vg, nLFg, nrow0, nhcol);
    __syncthreads();
    __builtin_amdgcn_sched_barrier(0);
    if (OUT) {
        const int jt = wid >> 1;
#pragma unroll
        for (int x = 0; x < 2; ++x) {
            const int it = (wid & 1) * 2 + x; f32x4 a = {0.f, 0.f, 0.f, 0.f};
            const bool dead = rev ? (it < jt) : (it > jt);
            if (!dead) {
#pragma unroll
                for (int kt = 0; kt < 4; ++kt) { const bf16x8 P = *(const LAS bf16x8*)(lds + KE_OFF + ((it * 16 + r) * RS128 + kt * 32 + 8 * q) * 2), Qf = *(const LAS bf16x8*)(lds + QE_OFF + ((jt * 16 + r) * RS128 + kt * 32 + 8 * q) * 2);
                    a = mfma16(P, Qf, a); }
            }
            const int j = jt * 16 + r;
#pragma unroll
            for (int e = 0; e < 4; ++e) { const int i = it * 16 + 4 * q + e; const bool keep = rev ? (i >= j) : (i <= j); if (!keep) a[e] = 0.f; }
            *(LAS u32x2*)(lds + AL_OFF + (j * RS64 + it * 16 + 4 * q) * 2) = (u32x2){cvt_pk_bf16(a[0], a[1]), cvt_pk_bf16(a[2], a[3])};
            __builtin_amdgcn_sched_barrier(0);
        }
        __syncthreads();
    }
    bf16x8 Pvt[2];
#pragma unroll
    for (int kt = 0; kt < 2; ++kt) Pvt[kt] = *(const LAS bf16x8*)(lds + VT_OFF + ((16 * wid + r) * RS64 + kt * 32 + 8 * q) * 2);
    if (OUT) {
        bf16x8 Pst[4];
#pragma unroll
        for (int kt = 0; kt < 4; ++kt) Pst[kt] = *(const LAS bf16x8*)(lds + ST_OFF + ((16 * wid + r) * RS128 + kt * 32 + 8 * q) * 2);
#pragma unroll
        for (int jt2 = 0; jt2 < 4; ++jt2) {
            bf16x8 Qd[4], Qa[2];
#pragma unroll
            for (int kt = 0; kt < 4; ++kt) Qd[kt] = *(const LAS bf16x8*)(lds + QD_OFF + ((jt2 * 16 + r) * RS128 + kt * 32 + 8 * q) * 2);
#pragma unroll
            for (int kt = 0; kt < 2; ++kt) Qa[kt] = *(const LAS bf16x8*)(lds + AL_OFF + ((jt2 * 16 + r) * RS64 + kt * 32 + 8 * q) * 2);
            f32x4 o = oacc[jt2];
#pragma unroll
            for (int kt = 0; kt < 4; ++kt) o = mfma16(Pst[kt], Qd[kt], o);
#pragma unroll
            for (int kt = 0; kt < 2; ++kt) o = mfma16(Pvt[kt], Qa[kt], o);
            oacc[jt2] = o;
            if (jt2 == 1) __builtin_amdgcn_sched_barrier(0);
        }
    }
#pragma unroll
    for (int dt = 0; dt < 8; ++dt) {
        const f32x4 bl = *(const LAS f32x4*)(BL + 16 * dt + 4 * q);
        bf16x8 Pk[2];
#pragma unroll
        for (int kt = 0; kt < 2; ++kt) Pk[kt] = *(const LAS bf16x8*)(lds + KDT_OFF + ((16 * dt + r) * RS64 + kt * 32 + 8 * q) * 2);
        f32x4 s = Sacc[dt]; s[0] *= __expf(bl[0]); s[1] *= __expf(bl[1]); s[2] *= __expf(bl[2]); s[3] *= __expf(bl[3]);
#pragma unroll
        for (int kt = 0; kt < 2; ++kt) s = mfma16(Pk[kt], Pvt[kt], s);
        Sacc[dt] = s;
        if (OUT) *(LAS u32x2*)(lds + ST_OFF + ((16 * wid + r) * RS128 + 16 * dt + 4 * q) * 2) = (u32x2){cvt_pk_bf16(s[0], s[1]), cvt_pk_bf16(s[2], s[3])};
        if ((dt & 3) == 3) __builtin_amdgcn_sched_barrier(0);
    }
}

__device__ __forceinline__ void scan_pass1(const Frame& F) {
    const bf16_t* Vg = (const bf16_t*)(F.ws + WS_R + R_V); const _Float16* LF = (const _Float16*)(F.ws + WS_R + R_LF);
    bf16_t* DS = (bf16_t*)(F.ws + WS_R + R_DS); float* DEC = (float*)(F.ws + WS_R + R_DEC);
    const int wid = F.wid, lane = F.lane, r = lane & 15, q = lane >> 4;
    int item = F.bid, cc = 0;
    ScanPre pre, nxt;
    int chain = item >> 6, n = ((item & 63) + 7 * chain) & 63, dir = chain & 1, bh = chain >> 1, b = bh / 6, h = bh % 6, nch = n == 0 ? 4 : 2;
    int rowbase = n == 0 ? ML + b * 256 : b * 8192 + (dir ? 63 - (n - 1) : (n - 1)) * 128;
    if (item < 24 * 64) scan_load<false>(F, pre, nullptr, Vg, LF + (size_t)dir * MT * DH, rowbase + 64 * (dir ? nch - 1 : 0), h * 128);
    f32x4 Sacc[8], odum[4]; float ld0 = 0.f, ld1 = 0.f;
#pragma unroll 1
    while (item < 24 * 64) {
        int item2 = item, cc2 = cc + 1; if (cc2 == nch) { cc2 = 0; item2 = item + F.G; }
        const bool has_next = item2 < 24 * 64;
        const int chain2 = item2 >> 6, n2 = ((item2 & 63) + 7 * chain2) & 63, dir2 = chain2 & 1, bh2 = chain2 >> 1, b2 = bh2 / 6, h2 = bh2 % 6, nch2 = n2 == 0 ? 4 : 2;
        const int rowbase2 = n2 == 0 ? ML + b2 * 256 : b2 * 8192 + (dir2 ? 63 - (n2 - 1) : (n2 - 1)) * 128;
        const int c2 = dir2 ? nch2 - 1 - cc2 : cc2;
        if (cc == 0) {
#pragma unroll
            for (int i = 0; i < 8; ++i) Sacc[i] = (f32x4){0.f, 0.f, 0.f, 0.f};
            ld0 = 0.f; ld1 = 0.f;
        }
        scan_chunk<false>(F, pre, nxt, has_next, nullptr, Vg, LF + (size_t)dir2 * MT * DH, rowbase2 + 64 * c2, h2 * 128, dir != 0, Sacc, odum, ld0, ld1);
        if (cc == nch - 1) {
            const int sid = (item >> 6) * 64 + (((item & 63) + 7 * (item >> 6)) & 63);
            bf16_t* slot = DS + (size_t)sid * 16384;
#pragma unroll
            for (int dt = 0; dt < 8; ++dt) *(u32x2*)(slot + (16 * wid + r) * 128 + 16 * dt + 4 * q) = (u32x2){cvt_pk_bf16(Sacc[dt][0], Sacc[dt][1]), cvt_pk_bf16(Sacc[dt][2], Sacc[dt][3])};
            if (wid == 0) *(f32x2*)(DEC + (size_t)sid * 128 + 2 * lane) = (f32x2){__expf(ld0), __expf(ld1)};
        }
        pre = nxt; item = item2; cc = cc2; dir = dir2; nch = nch2;
    }
    __syncthreads();
}
__device__ __forceinline__ void scan_pass2(const Frame& F) {
    bf16_t* DS = (bf16_t*)(F.ws + WS_R + R_DS); const float* DEC = (const float*)(F.ws + WS_R + R_DEC);
    for (int idx = F.bid * NTHR + F.tid; idx < 24 * 4096; idx += F.G * NTHR) {
        const int chain = idx >> 12, e4 = (idx & 4095) * 4, d = e4 & 127;
        bf16_t* p = DS + (size_t)chain * 64 * 16384 + e4; const float* dc = DEC + (size_t)chain * 64 * 128 + d;
        const u32x2 w = *(const u32x2*)p; float t0 = bf_lo(w.x), t1 = bf_hi(w.x), t2 = bf_lo(w.y), t3 = bf_hi(w.y);
#pragma unroll 16
        for (int m = 1; m < 64; ++m) { const u32x2 x = *(const u32x2*)(p + (size_t)m * 16384); const f32x4 de = *(const f32x4*)(dc + m * 128);
            t0 = de[0] * t0 + bf_lo(x.x); t1 = de[1] * t1 + bf_hi(x.x); t2 = de[2] * t2 + bf_lo(x.y); t3 = de[3] * t3 + bf_hi(x.y);
            *(u32x2*)(p + (size_t)m * 16384) = (u32x2){cvt_pk_bf16(t0, t1), cvt_pk_bf16(t2, t3)}; }
    }
}
__device__ __forceinline__ void scan_pass3(const Frame& F, const float* hgrn_norm_g) {
    const bf16_t* Qg = (const bf16_t*)(F.ws + WS_R + R_Q); const bf16_t* Vg = (const bf16_t*)(F.ws + WS_R + R_V); const bf16_t* GT = (const bf16_t*)(F.ws + WS_R + R_GT);
    const _Float16* LF = (const _Float16*)(F.ws + WS_R + R_LF); const bf16_t* DS = (const bf16_t*)(F.ws + WS_R + R_DS); bf16_t* HM = (bf16_t*)(F.ws + WS_H);
    LAS unsigned char* lds = F.lds; LAS float* RED = (LAS float*)(lds + RED_OFF);
    const int wid = F.wid, lane = F.lane, r = lane & 15, q = lane >> 4;
    ScanPre pre, nxt;
    u32x2 Spre[8];
    if (F.bid < 12 * 64) { const int bh0 = F.bid >> 6, mp0 = F.bid & 63; scan_load<true>(F, pre, Qg, Vg, LF, (bh0 / 6) * 8192 + mp0 * 128, (bh0 % 6) * 128);
        const bf16_t* slot0 = DS + (size_t)((bh0 * 2) * 64 + mp0) * 16384;
#pragma unroll
        for (int dt = 0; dt < 8; ++dt) Spre[dt] = *(const u32x2*)(slot0 + (16 * wid + r) * 128 + 16 * dt + 4 * q); }
#pragma unroll 1
    for (int item = F.bid; item < 12 * 64; item += F.G) {
        const int bh = item >> 6, mphys = item & 63, b = bh / 6, h = bh % 6, rowbase = b * 8192 + mphys * 128;
        f32x4 oacc[2][4];
#pragma unroll
        for (int c = 0; c < 2; ++c)
#pragma unroll
            for (int j = 0; j < 4; ++j) oacc[c][j] = (f32x4){0.f, 0.f, 0.f, 0.f};
        float ld0 = 0.f, ld1 = 0.f;
        f32x4 Sacc[8];
#pragma unroll 1
        for (int k = 0; k < 4; ++k) {
            const int dir = k >> 1;
            const int k2 = (k + 1) & 3, item2 = k == 3 ? item + F.G : item; const bool has_next = item2 < 12 * 64;
            const int bh2 = item2 >> 6, mp2 = item2 & 63, dir2 = k2 >> 1, c2 = dir2 ? 1 - (k2 & 1) : (k2 & 1);
            const int nrow0 = (bh2 / 6) * 8192 + mp2 * 128 + 64 * c2, nhcol = (bh2 % 6) * 128;
            if ((k & 1) == 0) {
#pragma unroll
                for (int dt = 0; dt < 8; ++dt) { const u32x2 w = Spre[dt]; Sacc[dt] = (f32x4){bf_lo(w.x), bf_hi(w.x), bf_lo(w.y), bf_hi(w.y)};
                    *(LAS u32x2*)(lds + ST_OFF + ((16 * wid + r) * RS128 + 16 * dt + 4 * q) * 2) = w; }
            } else if (has_next) {
                const int chain2 = bh2 * 2 + dir2, m2 = dir2 ? 63 - mp2 : mp2;
                const bf16_t* slot2 = DS + (size_t)(chain2 * 64 + m2) * 16384;
#pragma unroll
                for (int dt = 0; dt < 8; ++dt) Spre[dt] = *(const u32x2*)(slot2 + (16 * wid + r) * 128 + 16 * dt + 4 * q);
            }
            scan_chunk<true>(F, pre, nxt, has_next, Qg, Vg, LF + (size_t)dir2 * MT * DH, nrow0, nhcol, dir != 0, Sacc, oacc[0], ld0, ld1);
            pre = nxt;
            if ((k & 1) == 0) {
#pragma unroll
                for (int j = 0; j < 4; ++j) { const f32x4 t = oacc[0][j]; oacc[0][j] = oacc[1][j]; oacc[1][j] = t; }
            }
        }
#pragma unroll
        for (int c = 0; c < 2; ++c)
#pragma unroll
            for (int j = 0; j < 4; ++j) { const f32x4 o = oacc[c][j]; float ss = o[0] * o[0] + o[1] * o[1] + o[2] * o[2] + o[3] * o[3]; ss += __shfl_xor(ss, 16); ss += __shfl_xor(ss, 32);
                if (q == 0) RED[(64 * c + 16 * j + r) * 8 + wid] = ss; }
        __syncthreads();
        const int col = h * 128 + 16 * wid + 4 * q; const f32x4 gn = *(const f32x4*)(hgrn_norm_g + col);
        u32x2 gtv[2][4];
#pragma unroll
        for (int c = 0; c < 2; ++c)
#pragma unroll
            for (int j = 0; j < 4; ++j) gtv[c][j] = *(const u32x2*)(GT + (size_t)(rowbase + 64 * c + 16 * j + r) * DH + col);
#pragma unroll
        for (int c = 0; c < 2; ++c)
#pragma unroll
            for (int j = 0; j < 4; ++j) { const int tok = 64 * c + 16 * j + r; const f32x4 s0 = *(const LAS f32x4*)(RED + tok * 8), s1 = *(const LAS f32x4*)(RED + tok * 8 + 4);
                const float ss = (s0[0] + s0[1]) + (s0[2] + s0[3]) + (s1[0] + s1[1]) + (s1[2] + s1[3]); const float rstd = 1.0f / sqrtf(ss * (1.0f / 128.0f) + EPS);
                const size_t row = (size_t)(rowbase + tok); const u32x2 gt = gtv[c][j]; const f32x4 o = oacc[c][j];
                const float y0 = o[0] * rstd * gn[0] * bf_lo(gt.x), y1 = o[1] * rstd * gn[1] * bf_hi(gt.x), y2 = o[2] * rstd * gn[2] * bf_lo(gt.y), y3 = o[3] * rstd * gn[3] * bf_hi(gt.y);
                *(u32x2*)(HM + row * D + 256 + col) = (u32x2){cvt_pk_bf16(y0, y1), cvt_pk_bf16(y2, y3)}; }
        __syncthreads();
    }
}

__device__ __forceinline__ void pool_phase(const Frame& F, const float* pool_w, const float* pool_scale) {
    const float* PP = (const float*)(F.ws + WS_R + R_PP); bf16_t* HM = (bf16_t*)(F.ws + WS_H);
    LAS float* PL = (LAS float*)F.lds; LAS float* YL = (LAS float*)(F.lds + 65536);
    const int tid = F.tid;
    for (int item = F.bid; item < 256; item += F.G) {
        const int rowbase = item * 64;
        __syncthreads();
#pragma unroll
        for (int i = 0; i < 8; ++i) { const int e = (tid + NTHR * i) * 4, t = e >> 8, ch = e & 255; *(LAS f32x4*)(PL + t * 256 + ch) = *(const f32x4*)(PP + (size_t)(rowbase + t) * 256 + ch); }
        __syncthreads();
#pragma unroll
        for (int i = 0; i < 8; ++i) { const int e = (tid + NTHR * i) * 4, t = e >> 8, ch = e & 255, g = ch >> 6, w = 2 << g; int lo = t - (w >> 1), hi = lo + w; lo = lo < 0 ? 0 : lo; hi = hi > 64 ? 64 : hi;
            f32x4 s = {0.f, 0.f, 0.f, 0.f};
            for (int p = lo; p < hi; ++p) s += *(const LAS f32x4*)(PL + p * 256 + ch);
            const float inv = 1.0f / (float)(hi - lo);
            *(LAS f32x4*)(YL + t * 260 + ch) = s * inv - *(const LAS f32x4*)(PL + t * 256 + ch); }
        __syncthreads();
        {
            const int g = tid >> 7, tq = (tid >> 3) & 15, dq = tid & 7;
            f32x4 a[4][2];
#pragma unroll
            for (int k = 0; k < 4; ++k) { a[k][0] = (f32x4){0.f, 0.f, 0.f, 0.f}; a[k][1] = a[k][0]; }
            const float* wp = pool_w + (size_t)g * 4096 + dq * 8;
#pragma unroll 4
            for (int c = 0; c < 64; ++c) { const f32x4 w0 = *(const f32x4*)(wp + c * 64), w1 = *(const f32x4*)(wp + c * 64 + 4);
#pragma unroll
                for (int k = 0; k < 4; ++k) { const float y = YL[(tq + 16 * k) * 260 + g * 64 + c]; a[k][0] += w0 * y; a[k][1] += w1 * y; } }
            const f32x4 s0 = *(const f32x4*)(pool_scale + g * 64 + dq * 8), s1 = *(const f32x4*)(pool_scale + g * 64 + dq * 8 + 4);
#pragma unroll
            for (int k = 0; k < 4; ++k) { const f32x4 x0 = a[k][0] * s0, x1 = a[k][1] * s1;
                u32x4 w; w.x = cvt_pk_bf16(x0[0], x0[1]); w.y = cvt_pk_bf16(x0[2], x0[3]); w.z = cvt_pk_bf16(x1[0], x1[1]); w.w = cvt_pk_bf16(x1[2], x1[3]);
                *(u32x4*)(HM + (size_t)(rowbase + tq + 16 * k) * D + g * 64 + dq * 8) = w; }
        }
    }
    __syncthreads();
}

__device__ __forceinline__ void gmlp_phase(const Frame& F, const float* ln_g, const float* ln_b, const float* b_s) {
    const bf16_t* U = (const bf16_t*)(F.ws + WS_R + R_U); const bf16_t* VG = (const bf16_t*)(F.ws + WS_R + R_VG); const bf16_t* WSB = (const bf16_t*)(F.ws + WS_WS); bf16_t* HM = (bf16_t*)(F.ws + WS_H);
    LAS unsigned char* lds = F.lds; constexpr int VNT_OFF = 0, WSL_OFF = 34816, STAT_OFF = 69632;
    LAS float* STAT = (LAS float*)(lds + STAT_OFF);
    const int tid = F.tid, wid = F.wid, lane = F.lane, r = lane & 15, q = lane >> 4;
    for (int item = F.bid; item < 256; item += F.G) {
        const int n = item >> 1, gh = item & 1, rowbase = n * 128;
        __syncthreads();
#pragma unroll 1
        for (int i0 = 0; i0 < 16; i0 += 4) {
            u32x4 ra[4], rb[4];
#pragma unroll
            for (int t = 0; t < 4; ++t) { const bf16_t* p = VG + (size_t)(rowbase + 16 * wid + i0 + t) * D + lane * 16; ra[t] = *(const u32x4*)p; rb[t] = *(const u32x4*)(p + 8); }
#pragma unroll
            for (int t = 0; t < 4; ++t) { const int tk = 16 * wid + i0 + t; float s = 0.f, ss = 0.f;
                const unsigned ws8[8] = {ra[t].x, ra[t].y, ra[t].z, ra[t].w, rb[t].x, rb[t].y, rb[t].z, rb[t].w};
#pragma unroll
                for (int k = 0; k < 8; ++k) { const float lo = bf_lo(ws8[k]), hi = bf_hi(ws8[k]); s += lo + hi; ss += lo * lo + hi * hi; }
#pragma unroll
                for (int o = 32; o >= 1; o >>= 1) { s += __shfl_xor(s, o); ss += __shfl_xor(ss, o); }
                const float mean = s * (1.0f / D); float var = ss * (1.0f / D) - mean * mean; var = var < 0.f ? 0.f : var;
                if (lane == 0) *(LAS f32x2*)(STAT + tk * 2) = (f32x2){mean, 1.0f / sqrtf(var + EPS)}; }
        }
        __syncthreads();
#pragma unroll 1
        for (int gi = 0; gi < 4; ++gi) {
            const int g = gh * 4 + gi;
#pragma unroll
            for (int i = 0; i < 4; ++i) { const int id = tid + NTHR * i, p = id >> 4, q8 = (id & 15) * 8; *(LAS u32x4*)(lds + WSL_OFF + (p * RS128 + q8) * 2) = *(const u32x4*)(WSB + (size_t)g * 16384 + p * 128 + q8); }
            {
                const int c0 = g * 128 + 2 * lane; const f32x2 lg = *(const f32x2*)(ln_g + c0), lb2 = *(const f32x2*)(ln_b + c0);
                unsigned lo8[8], hi8[8]; float pl = 0.f, ph = 0.f;
#pragma unroll
                for (int i = 0; i < 16; ++i) { const int tk = 16 * wid + i; const unsigned x = *(const unsigned*)(VG + (size_t)(rowbase + tk) * D + c0); const f32x2 st = *(const LAS f32x2*)(STAT + tk * 2);
                    const float y0 = (bf_lo(x) - st.x) * st.y * lg.x + lb2.x, y1 = (bf_hi(x) - st.x) * st.y * lg.y + lb2.y;
                    if (i & 1) { lo8[i >> 1] = cvt_pk_bf16(pl, y0); hi8[i >> 1] = cvt_pk_bf16(ph, y1); } else { pl = y0; ph = y1; } }
                *(LAS u32x4*)(lds + VNT_OFF + ((2 * lane) * RS128 + 16 * wid) * 2) = (u32x4){lo8[0], lo8[1], lo8[2], lo8[3]}; *(LAS u32x4*)(lds + VNT_OFF + ((2 * lane) * RS128 + 16 * wid + 8) * 2) = (u32x4){lo8[4], lo8[5], lo8[6], lo8[7]};
                *(LAS u32x4*)(lds + VNT_OFF + ((2 * lane + 1) * RS128 + 16 * wid) * 2) = (u32x4){hi8[0], hi8[1], hi8[2], hi8[3]}; *(LAS u32x4*)(lds + VNT_OFF + ((2 * lane + 1) * RS128 + 16 * wid + 8) * 2) = (u32x4){hi8[4], hi8[5], hi8[6], hi8[7]};
            }
            __syncthreads();
            f32x4 acc[8];
#pragma unroll
            for (int ct = 0; ct < 8; ++ct) acc[ct] = (f32x4){0.f, 0.f, 0.f, 0.f};
#pragma unroll
            for (int kt = 0; kt < 4; ++kt) { const bf16x8 Qf = *(const LAS bf16x8*)(lds + WSL_OFF + ((16 * wid + r) * RS128 + kt * 32 + 8 * q) * 2);
#pragma unroll
                for (int ct = 0; ct < 8; ++ct) { const bf16x8 P = *(const LAS bf16x8*)(lds + VNT_OFF + ((16 * ct + r) * RS128 + kt * 32 + 8 * q) * 2); acc[ct] = mfma16(P, Qf, acc[ct]); } __builtin_amdgcn_sched_barrier(0); }
            const int tk = 16 * wid + r; const float bs = b_s[g * 128 + tk]; const size_t rowo = (size_t)(rowbase + tk) * D + g * 128 + 4 * q;
            u32x2 uu[8];
#pragma unroll
            for (int ct = 0; ct < 8; ++ct) uu[ct] = *(const u32x2*)(U + rowo + 16 * ct);
#pragma unroll
            for (int ct = 0; ct < 8; ++ct) { const u32x2 u2 = uu[ct]; const f32x4 a = acc[ct];
                *(u32x2*)(HM + rowo + 16 * ct) = (u32x2){cvt_pk_bf16(bf_lo(u2.x) * (a[0] + bs), bf_hi(u2.x) * (a[1] + bs)), cvt_pk_bf16(bf_lo(u2.y) * (a[2] + bs), bf_hi(u2.y) * (a[3] + bs))}; }
            __syncthreads();
        }
    }
}

#define XB_TMO      128
#define XB_XCNT(j)  (256  + 64 * (j))
#define XB_XSUB(j)  (1280 + 64 * (j))
#define XB_XGEN(j)  (2304 + 64 * (j))
#define XB_TOP      3328
#define XB_TOPGEN   3392
#define XCD_BAR_WORDS 3456
#define XB_SPIN_CAP (1u << 18)

__device__ __forceinline__ unsigned xb_ld(unsigned* p)              { return __hip_atomic_load(p, __ATOMIC_RELAXED, __HIP_MEMORY_SCOPE_AGENT); }
__device__ __forceinline__ unsigned xb_add(unsigned* p, unsigned v) { return __hip_atomic_fetch_add(p, v, __ATOMIC_RELAXED, __HIP_MEMORY_SCOPE_AGENT); }
__device__ __forceinline__ unsigned xb_xcc_id() { return (unsigned)__builtin_amdgcn_s_getreg((3 << 11) | 20) & 0xFu; }
#define XB_SPIN(cond, bar) do { unsigned _sp = 0; while (cond) { __builtin_amdgcn_s_sleep(1); \
    if ((++_sp & 255u) == 0u) { if (xb_ld(&(bar)[XB_TMO])) break; if (_sp > XB_SPIN_CAP) { atomicAdd(&(bar)[XB_TMO], 1u); break; } } } } while (0)

struct XcdBarrier {
    unsigned* bar; unsigned x;
    volatile LAS unsigned* st;
};

__device__ __forceinline__ XcdBarrier xcd_barrier_post(unsigned* bar, volatile LAS unsigned* st) {
    XcdBarrier b; b.bar = bar; b.x = xb_xcc_id(); b.st = st;
    if (threadIdx.x == 0) (void)xb_add(&bar[XB_XCNT(b.x)], 1u);
    return b;
}
__device__ __forceinline__ void xcd_barrier_complete(unsigned* bar, unsigned x, unsigned& nloc, unsigned& nx) {
    const unsigned G = gridDim.x * gridDim.y * gridDim.z;
    unsigned sum, cnt, mine, sp = 0u;
    for (;;) {
        sum = 0u; cnt = 0u; mine = 0u;
#pragma unroll
        for (unsigned j = 0; j < 16; ++j) { const unsigned c = xb_ld(&bar[XB_XCNT(j)]); sum += c; cnt += (c > 0u) ? 1u : 0u; mine = (j == x) ? c : mine; }
        if (sum == G) break;
        __builtin_amdgcn_s_sleep(1);
        if ((++sp & 255u) == 0u) { if (xb_ld(&bar[XB_TMO])) break; if (sp > XB_SPIN_CAP) { atomicAdd(&bar[XB_TMO], 1u); break; } }
    }
    nloc = mine > 0u ? mine : 1u; nx = cnt > 0u ? cnt : 1u;
}

__device__ __forceinline__ void xcd_barrier(const XcdBarrier& b) {
    asm volatile("s_waitcnt vmcnt(0)" ::: "memory");
    __syncthreads();
    if (threadIdx.x == 0) {
        unsigned* bar = b.bar;
        __builtin_amdgcn_s_waitcnt(0);
        unsigned nloc = b.st[0], nx = b.st[1];
        if (nloc == 0u) { xcd_barrier_complete(bar, b.x, nloc, nx); b.st[0] = nloc; b.st[1] = nx; }
        const unsigned old = xb_add(&bar[XB_XSUB(b.x)], 1u);
        const unsigned gen = old / nloc;
        if (old + 1u == (gen + 1u) * nloc) {
            __builtin_amdgcn_fence(__ATOMIC_RELEASE, "agent");
            asm volatile("s_waitcnt vmcnt(0)" ::: "memory");
            const unsigned og = xb_add(&bar[XB_TOP], 1u);
            const unsigned tg = og / nx;
            if (og + 1u == (tg + 1u) * nx) xb_add(&bar[XB_TOPGEN], 1u);
            else XB_SPIN(xb_ld(&bar[XB_TOPGEN]) == tg, bar);
            __builtin_amdgcn_fence(__ATOMIC_ACQUIRE, "agent");
            xb_add(&bar[XB_XGEN(b.x)], 1u);
            asm volatile("s_waitcnt vmcnt(0)" ::: "memory");
        } else {
            XB_SPIN(xb_ld(&bar[XB_XGEN(b.x)]) == gen, bar);
            __builtin_amdgcn_fence(__ATOMIC_ACQUIRE, "agent");
            asm volatile("s_waitcnt vmcnt(0)" ::: "memory");
        }
    }
    __syncthreads();
}

__global__ void __launch_bounds__(NTHR) mega_fwd(Args args) {
    extern __shared__ __attribute__((aligned(16))) unsigned char lds_raw[];
    cg::grid_group grid = cg::this_grid();
    Frame F;
    F.lds = (LAS unsigned char*)lds_raw; F.tid = threadIdx.x; F.lane = F.tid & 63; F.wid = __builtin_amdgcn_readfirstlane(F.tid >> 6); F.G = gridDim.x; F.bid = blockIdx.x;
    F.out = args.out; F.ws = args.ws;
    unsigned char* ws = F.ws;
    float* XL = F.out; float* XC = (float*)(ws + WS_XC); bf16_t* H = (bf16_t*)(ws + WS_H); bf16_t* G = (bf16_t*)(ws + WS_R + R_G);
    const float* MOD0 = (const float*)(ws + WS_MOD); const float* MOD1 = MOD0 + 3 * NMODD;
    const int lo = args.ph_lo, hi = args.ph_hi;
    if (lo < -1) grid.sync();
    volatile LAS unsigned* bst = (volatile LAS unsigned*)(F.lds + LDS_BYTES - 16);
    if (F.tid < 4) bst[F.tid] = 0u;
    __syncthreads();
    const XcdBarrier xbar = xcd_barrier_post((unsigned*)(ws + WS_BAR), bst);
#define IN(k) (lo <= (k) && (k) < hi)
#ifndef PROBE_MASK
#define PROBE_MASK 0u
#endif
#ifndef PROBE_SCALE
#define PROBE_SCALE 1.0f
#endif
    unsigned long long* TS = (unsigned long long*)(ws + 2048);
    const bool stamper = PROBE_MASK != 0u && F.bid == 0 && F.tid == 0;
    if (stamper) TS[0] = __builtin_amdgcn_s_memrealtime();
#define SEAM(k) do { if (IN(k) && IN((k) + 1)) { xcd_barrier(xbar); } if (stamper) TS[(k) + 1] = __builtin_amdgcn_s_memrealtime(); } while (0)
    if (IN(0)) mod_phase(F, args.in[1], args.in[3], args.in[4], args.in[5], args.in[19]); SEAM(0);
    if (IN(1)) { norm_phase(F, args.in[0], args.in[2], MT, args.in[6] + 0 * D, MOD0, 0, H); run_tjobs(F, args, 0, 0x13u, 0, F.G); } SEAM(1);
    if (IN(2)) { run_gemm(F, H, (const bf16_t*)(ws + WS_UP0), MT, 2 * DFF, D, EpiSwiGlu{G}); run_tjobs(F, args, 0, 0x40u, 172, F.G - 172); } SEAM(2);
    if (IN(3)) { run_gemm(F, G, (const bf16_t*)(ws + WS_DN0), ML, D, DFF, EpiResid{args.in[0], args.in[2], XL, XC, MOD0 + 2 * 1024, 0.5f});
        run_ctx_down_splitk(F, G + (size_t)ML * DFF, (const bf16_t*)(ws + WS_DN0), (float*)(ws + WS_R + R_PART)); } SEAM(3);
    if (IN(4)) norm_phase(F, XL, args.in[2], MT, args.in[6] + 1 * D, MOD0, 1, H, (const float*)(ws + WS_R + R_PART), MOD0 + 2 * NMODD + 2 * 1024); SEAM(4);
    if (IN(5)) { run_gemm(F, H, (const bf16_t*)(ws + WS_WIN), MT, DIN, D, EpiWin{ws + WS_R, args.in[13]}); run_tjobs(F, args, 0, 0x3ACu, 32, F.G - 32); } SEAM(5);
    if (IN(6)) scan_pass1(F); SEAM(6);
    if (IN(7)) { scan_pass2(F); pool_phase(F, args.in[11], args.in[12]); } SEAM(7);
    if (IN(8)) scan_pass3(F, args.in[14]); SEAM(8);
    if (IN(9)) run_gemm(F, H, (const bf16_t*)(ws + WS_WOUT), ML, D, D, EpiResid{XL, XC, XL, XC, MOD0 + 5 * 1024, 1.0f}); SEAM(9);
    if (IN(10)) norm_phase(F, XL, XC, ML, args.in[6] + 2 * D, MOD0, 2, H); SEAM(10);
    if (IN(11)) { run_gemm(F, H, (const bf16_t*)(ws + WS_UP0 + SZ_UP), ML, 2 * DFF, D, EpiSwiGlu{G}); run_tjobs(F, args, 1, 0x13u, 128, F.G - 128); } SEAM(11);
    if (IN(12)) run_gemm(F, G, (const bf16_t*)(ws + WS_DN0 + SZ_DN), ML, D, DFF, EpiResid{XL, XC, XL, XC, MOD0 + 8 * 1024, 0.5f}); SEAM(12);
    if (IN(13)) norm_phase(F, XL, XC, ML, args.in[6] + 3 * D, MOD1, 0, H); SEAM(13);
    if (IN(14)) { run_gemm(F, H, (const bf16_t*)(ws + WS_R + R_UP1), ML, 2 * DFF, D, EpiSwiGlu{G}); run_tjobs(F, args, 1, 0x2Cu, 128, F.G - 128); } SEAM(14);
    if (IN(15)) run_gemm(F, G, (const bf16_t*)(ws + WS_R + R_DN1), ML, D, DFF, EpiResid{XL, XC, XL, XC, MOD1 + 2 * 1024, 0.5f}); SEAM(15);
    if (IN(16)) norm_phase(F, XL, XC, ML, args.in[6] + 4 * D, MOD1, 1, H); SEAM(16);
    if (IN(17)) run_gemm(F, H, (const bf16_t*)(ws + WS_GIN), ML, 2 * D, D, EpiGin{(bf16_t*)(ws + WS_R + R_U), (bf16_t*)(ws + WS_R + R_VG)}); SEAM(17);
    if (IN(18)) gmlp_phase(F, args.in[17], args.in[18], args.in[20]); SEAM(18);
    if (IN(19)) run_gemm(F, H, (const bf16_t*)(ws + WS_GOUT), ML, D, D, EpiResid{XL, XC, XL, XC, MOD1 + 5 * 1024, 1.0f}); SEAM(19);
    if (IN(20)) norm_phase(F, XL, XC, ML, args.in[6] + 5 * D, MOD1, 2, H); SEAM(20);
    if (IN(21)) run_gemm(F, H, (const bf16_t*)(ws + WS_R + R_UP1 + SZ_UP), ML, 2 * DFF, D, EpiSwiGlu{G}); SEAM(21);
    if (IN(22)) run_gemm(F, G, (const bf16_t*)(ws + WS_R + R_DN1 + SZ_DN), ML, D, DFF, EpiResid{XL, XC, XL, XC, MOD1 + 8 * 1024, 0.5f}); SEAM(22);
    if (IN(23)) final_norm_phase(F, XL, args.in[22]);
    if (PROBE_MASK != 0u && F.bid == 0) { __syncthreads(); if (F.tid == 0) { TS[24] = __builtin_amdgcn_s_memrealtime(); unsigned long long tot = 0;
        for (int k = 0; k < 24; ++k) if ((PROBE_MASK >> k) & 1u) tot += TS[k + 1] - TS[k];
        F.out[0] = (float)tot * 1e-5f * PROBE_SCALE; } }
}
constexpr int NPHASES = 24;
#ifndef MK_PER_PHASE
#define MK_PER_PHASE 0
#endif

extern "C" void kernel_launch(void* const* d_in, const int* in_sizes, int n_in, void* d_out, int out_size, void* d_ws, size_t ws_size, hipStream_t stream) {
    static int grid = 0;
    if (grid == 0) {
        if (n_in != 23 || out_size != ML * D || ws_size < WS_END) { fprintf(stderr, "kernel_launch: unexpected shapes (n_in %d out %d ws %zu need %zu)\n", n_in, out_size, ws_size, (size_t)WS_END); grid = -1; return; }
        int dev = 0, cus = 0, per_cu = 0;
        hipGetDevice(&dev); hipDeviceGetAttribute(&cus, hipDeviceAttributeMultiprocessorCount, dev);
        hipFuncSetAttribute((const void*)mega_fwd, hipFuncAttributeMaxDynamicSharedMemorySize, LDS_BYTES);
        hipOccupancyMaxActiveBlocksPerMultiprocessor(&per_cu, (const void*)mega_fwd, NTHR, LDS_BYTES);
        if (per_cu < 1) { fprintf(stderr, "kernel_launch: occupancy query says %d blocks per CU\n", per_cu); per_cu = 1; }
        (void)hipGetLastError();
        grid = cus;
    }
    if (grid < 0) return;
    if (hipMemsetAsync((unsigned char*)d_ws + WS_BAR, 0, XCD_BAR_WORDS * 4, stream) != hipSuccess) { fprintf(stderr, "kernel_launch: memset failed\n"); return; }
    Args a{};
    for (int i = 0; i < 23; ++i) a.in[i] = (const float*)d_in[i];
    a.out = (float*)d_out; a.ws = (unsigned char*)d_ws;
#if MK_PER_PHASE
    for (int p = 0; p < NPHASES; ++p) { a.ph_lo = p; a.ph_hi = p + 1; hipLaunchKernelGGL(mega_fwd, dim3(grid), dim3(NTHR), LDS_BYTES, stream, a); }
#else
    a.ph_lo = 0; a.ph_hi = NPHASES;
    void* kargs[] = {&a};
    hipError_t e = hipLaunchCooperativeKernel((const void*)mega_fwd, dim3(grid), dim3(NTHR), kargs, LDS_BYTES, stream);
    if (e != hipSuccess) fprintf(stderr, "kernel_launch: cooperative launch failed: %s (grid %d)\n", hipGetErrorString(e), grid);
#endif
}
```

```cpp
#include <hip/hip_runtime.h>
#include <hip/hip_cooperative_groups.h>
#include <cstdio>
namespace cg = cooperative_groups;
namespace pg8 {
#define PG8_LAS __attribute__((address_space(3)))
typedef unsigned short bf16_t;
typedef short bf16x8 __attribute__((ext_vector_type(8)));
typedef float f32x4 __attribute__((ext_vector_type(4)));
typedef unsigned u32x4 __attribute__((ext_vector_type(4)));
constexpr int BM = 256, BK = 64, HALF = 128, HTB = HALF * BK * 2  , STAGE_BYTES = 8 * HTB, NXCD = 8, WGM = 8;

__host__ __device__ __forceinline__ int lds_byte(int r, int c) { const int st = (r >> 4) * 2 + (c >> 5), rr = r & 15, cc = c & 31, ob = rr * 64 + cc * 2; return st * 1024 + (ob ^ (((ob >> 9) & 1) << 5)); }
__host__ __device__ __forceinline__ void stage_rc(int b, int& R, int& C) { const int st = b / 1024, sb = b % 1024, swz = sb ^ (((sb >> 9) & 1) << 5); R = (st >> 1) * 16 + swz / 64; C = (st & 1) * 32 + (swz % 64) / 2; }
__host__ __device__ __forceinline__ int perm32(int rho) { const int n = rho >> 4, i = rho & 15; return 8 * (i >> 2) + 4 * n + (i & 3); }

struct Unit { int pm, pn; };
struct Gemm { const bf16_t* A; const bf16_t* Bt; int M, N, K, ld; };

struct StaticOrder {
    int nM, nN, nwg, G, c;
    __host__ __device__ void init(int M, int N, int G_, int c_) { nM = M / BM; nN = N / BM; nwg = nM * nN; G = G_; c = c_; }
    __host__ __device__ bool next(int i, Unit& u) const {
        const long L = (long)i * G + c; if (L >= nwg) return false;
        int wgid = (int)L; { const int q = nwg / NXCD, r = nwg % NXCD, xcd = wgid % NXCD, off = wgid / NXCD; wgid = (xcd < r ? xcd * (q + 1) : r * (q + 1) + (xcd - r) * q) + off; }
        const int nig = WGM * nN, gid = wgid / nig, fm = gid * WGM, gsz = (nM - fm) < WGM ? (nM - fm) : WGM;
        u.pm = fm + ((wgid % nig) % gsz); u.pn = (wgid % nig) / gsz; return true;
    }
    __device__ __forceinline__ void a_ready(const Unit&) const {}
    __device__ __forceinline__ void done(const Unit&) const {}
};
typedef __bf16 bf16v2_t __attribute__((ext_vector_type(2)));
typedef float f32v2_t __attribute__((ext_vector_type(2)));
__device__ __forceinline__ unsigned cvt_pk_bf16(float lo, float hi) { const f32v2_t v = {lo, hi}; const bf16v2_t b = __builtin_convertvector(v, bf16v2_t); return __builtin_bit_cast(unsigned, b); }
template <class Epi, class Sched, bool STAMP = false>
__device__ __forceinline__ void gemm_phase(PG8_LAS unsigned char* lds, const Gemm g, const Sched& S, const Epi& E, unsigned long long* stamps) {
    const int tid = threadIdx.x, wid = __builtin_amdgcn_readfirstlane(tid >> 6), lane = tid & 63, wr = wid >> 2, wc = wid & 3, fr = lane & 15, fq = lane >> 4;
    const int K = g.K, nt = K / BK, ld = g.ld;
    int ts_lo = 0, ts_hi = 0, nts = 0; const unsigned long long rt_entry = STAMP ? (unsigned long long)wall_clock64() : 0ull;
#define PG8_STAMP() do { if (STAMP && wid == 0 && nts < 64) { const unsigned long long _c = (unsigned long long)clock64(); \
        ts_lo = (lane == nts) ? (int)(unsigned)_c : ts_lo; ts_hi = (lane == nts) ? (int)(unsigned)(_c >> 32) : ts_hi; ++nts; } } while (0)
    PG8_STAMP();
    unsigned voffA[2], voffB[2];
#pragma unroll
    for (int i = 0; i < 2; ++i) { int R, C; stage_rc(tid * 16 + i * 8192, R, C); const int Rb = Epi::PERM ? ((R & ~31) + perm32(R & 31)) : R;
        voffA[i] = (unsigned)(R * ld + C) * 2u; voffB[i] = (unsigned)(Rb * ld + C) * 2u; }
    const size_t kstep = (size_t)(BK * 2);
    const size_t hstep = (size_t)HALF * ld * 2;
    const size_t tstep = 2 * hstep;
    const unsigned ldsw = (unsigned)wid * 1024u;
    const int aoff = lds_byte(wr * 64 + fr, fq * 8), boff = lds_byte(wc * 32 + fr, fq * 8);
#define PG8_SA(b, h) (((b) * 2 + (h)) * HTB)
#define PG8_SB(b, h) ((4 + (b) * 2 + (h)) * HTB)
#define PG8_STAGE(bufoff, gbase, voff) do { _Pragma("unroll") for (int _i = 0; _i < 2; ++_i) \
        __builtin_amdgcn_global_load_lds((const unsigned*)((const char*)(gbase) + (voff)[_i]), (PG8_LAS unsigned*)(lds + (bufoff) + ldsw + _i * 8192), 16, 0, 0); } while (0)
#define PG8_LDA(dst, b, h) do { _Pragma("unroll") for (int m = 0; m < 4; ++m) _Pragma("unroll") for (int k = 0; k < 2; ++k) dst[m][k] = *(const PG8_LAS bf16x8*)(lds + PG8_SA(b, h) + aoff + m * 2048 + k * 1024); } while (0)
#define PG8_LDB(dst, b, h) do { _Pragma("unroll") for (int n = 0; n < 2; ++n) _Pragma("unroll") for (int k = 0; k < 2; ++k) dst[n][k] = *(const PG8_LAS bf16x8*)(lds + PG8_SB(b, h) + boff + n * 2048 + k * 1024); } while (0)
#define PG8_MMA(ai, bj, At, Bt) do { __builtin_amdgcn_s_setprio(1); _Pragma("unroll") for (int m = 0; m < 4; ++m) _Pragma("unroll") for (int n = 0; n < 2; ++n) _Pragma("unroll") for (int k = 0; k < 2; ++k) \
        acc[ai][bj][m][n] = __builtin_amdgcn_mfma_f32_16x16x32_bf16(Bt[n][k], At[m][k], acc[ai][bj][m][n], 0, 0, 0); __builtin_amdgcn_s_setprio(0); } while (0)
#define PG8_WAIT_V(n) asm volatile("s_waitcnt vmcnt(" #n ")" ::: "memory")
#define PG8_WAIT_L(n) asm volatile("s_waitcnt lgkmcnt(" #n ")" ::: "memory")
#define PG8_BAR __builtin_amdgcn_s_barrier()
#define PG8_SCHED __builtin_amdgcn_sched_barrier(0)
    Unit cur, nxt; int ui = 0;
    if (!S.next(0, cur)) return;
    f32x4 acc[2][2][4][2];
#pragma unroll
    for (int a = 0; a < 2; ++a)
#pragma unroll
        for (int b = 0; b < 2; ++b)
#pragma unroll
            for (int m = 0; m < 4; ++m)
#pragma unroll
                for (int n = 0; n < 2; ++n) acc[a][b][m][n] = (f32x4){0.f, 0.f, 0.f, 0.f};
    bf16x8 At[4][2], B0[2][2], B1[2][2];
    const char* cA = (const char*)g.A + (size_t)cur.pm * tstep; const char* cB = (const char*)g.Bt + (size_t)cur.pn * tstep;
    S.a_ready(cur);
    PG8_STAGE(PG8_SB(0, 0), cB, voffB); PG8_STAGE(PG8_SA(0, 0), cA, voffA); PG8_STAGE(PG8_SB(0, 1), cB + hstep, voffB); PG8_STAGE(PG8_SA(0, 1), cA + hstep, voffA);
    if (wr == 1) PG8_BAR;
    PG8_WAIT_V(4); PG8_BAR;
    PG8_STAGE(PG8_SB(1, 0), cB + kstep, voffB); PG8_STAGE(PG8_SA(1, 0), cA + kstep, voffA); PG8_STAGE(PG8_SB(1, 1), cB + hstep + kstep, voffB);
    PG8_WAIT_V(6); PG8_BAR;
    PG8_STAMP();
    for (;;) {
        const bool has_next = S.next(ui + 1, nxt);
        const char* nA = has_next ? (const char*)g.A + (size_t)nxt.pm * tstep : cA; const char* nB = has_next ? (const char*)g.Bt + (size_t)nxt.pn * tstep : cB;
        for (int t = 0; t < nt; t += 2) {
            const bool last = (t == nt - 2);
            const char* a1 = cA + (size_t)(t + 1) * kstep;
            const char* a2 = last ? nA : cA + (size_t)(t + 2) * kstep; const char* b2 = last ? nB : cB + (size_t)(t + 2) * kstep;
            const char* a3 = a2 + kstep; const char* b3 = b2 + kstep;
            if (last && has_next) S.a_ready(nxt);
            PG8_LDB(B0, 0, 0); PG8_SCHED; PG8_LDA(At, 0, 0); PG8_STAGE(PG8_SA(1, 1), a1 + hstep, voffA);
            PG8_WAIT_L(8); PG8_BAR; PG8_WAIT_L(0); PG8_MMA(0, 0, At, B0); PG8_BAR; PG8_SCHED;
            PG8_LDB(B1, 0, 1); PG8_STAGE(PG8_SB(0, 0), b2, voffB);
            PG8_BAR; PG8_WAIT_L(0); PG8_MMA(0, 1, At, B1); PG8_BAR;
            PG8_LDA(At, 0, 1); PG8_STAGE(PG8_SA(0, 0), a2, voffA);
            PG8_BAR; PG8_WAIT_L(0); PG8_MMA(1, 0, At, B0); PG8_BAR; PG8_SCHED;
            PG8_STAGE(PG8_SB(0, 1), b2 + hstep, voffB);
            PG8_WAIT_V(6); PG8_BAR; PG8_MMA(1, 1, At, B1); PG8_BAR;
            PG8_LDB(B0, 1, 0); PG8_SCHED; PG8_LDA(At, 1, 0); PG8_STAGE(PG8_SA(0, 1), a2 + hstep, voffA);
            PG8_WAIT_L(8); PG8_BAR; PG8_WAIT_L(0); PG8_MMA(0, 0, At, B0); PG8_BAR; PG8_SCHED;
            PG8_LDB(B1, 1, 1); PG8_STAGE(PG8_SB(1, 0), b3, voffB);
            PG8_BAR; PG8_WAIT_L(0); PG8_MMA(0, 1, At, B1); PG8_BAR;
            PG8_LDA(At, 1, 1); PG8_STAGE(PG8_SA(1, 0), a3, voffA);
            PG8_BAR; PG8_WAIT_L(0); PG8_MMA(1, 0, At, B0); PG8_BAR; PG8_SCHED;
            PG8_STAGE(PG8_SB(1, 1), b3 + hstep, voffB);
            PG8_WAIT_V(6); PG8_BAR; PG8_MMA(1, 1, At, B1); PG8_BAR;
        }
        PG8_STAMP();
        if constexpr (!Epi::AFTER_DRAIN) { E(acc, cur, wr, wc, fr, fq); S.done(cur); }
        PG8_STAMP();
        if (!has_next) break;
#pragma unroll
        for (int a = 0; a < 2; ++a)
#pragma unroll
            for (int b = 0; b < 2; ++b)
#pragma unroll
                for (int m = 0; m < 4; ++m)
#pragma unroll
                    for (int n = 0; n < 2; ++n) acc[a][b][m][n] = (f32x4){0.f, 0.f, 0.f, 0.f};
        cur = nxt; cA = nA; cB = nB; ++ui;
    }
    PG8_WAIT_V(0);
    if (wr == 0) PG8_BAR;
    PG8_BAR;
    if constexpr (Epi::AFTER_DRAIN) { E.fused(acc, cur, wr, wc, fr, fq, lds, wid, lane); S.done(cur); }
    PG8_STAMP();
    if (STAMP && wid == 0) { stamps[lane] = lane < nts ? (((unsigned long long)(unsigned)ts_hi << 32) | (unsigned)ts_lo) : 0ull;
        if (lane == 62) stamps[62] = rt_entry; if (lane == 63) stamps[63] = (unsigned long long)wall_clock64(); }
#undef PG8_STAMP
#undef PG8_SA
#undef PG8_SB
#undef PG8_STAGE
#undef PG8_LDA
#undef PG8_LDB
#undef PG8_MMA
#undef PG8_WAIT_V
#undef PG8_WAIT_L
#undef PG8_BAR
#undef PG8_SCHED
}
}

using pg8::bf16_t; using pg8::bf16x8; using pg8::f32x4; using pg8::u32x4; using pg8::Unit; using pg8::cvt_pk_bf16;
#define LAS __attribute__((address_space(3)))
typedef float f32x2 __attribute__((ext_vector_type(2)));
typedef unsigned u32x2 __attribute__((ext_vector_type(2)));
typedef _Float16 f16x2 __attribute__((ext_vector_type(2)));
typedef _Float16 f16x8 __attribute__((ext_vector_type(8)));

constexpr int D = 1024, ML = 16384, MC = 512, MT = ML + MC, DFF = 2816, DH = 768, DIN = 4096, NMODD = 9 * 1024;
constexpr float EPS = 1e-6f;
constexpr int NTHR = 512;
constexpr int LDS_BYTES = 147456;

constexpr size_t al256(size_t x) { return (x + 255) & ~(size_t)255; }
constexpr size_t WS_BAR   = 4096;
constexpr size_t WS_MOD   = 4096 + 16384;
constexpr size_t WS_XC    = al256(WS_MOD + (size_t)2 * 3 * NMODD * 4);
constexpr size_t SZ_UP    = (size_t)2 * DFF * D * 2;
constexpr size_t SZ_DN    = (size_t)D * DFF * 2;
constexpr size_t WS_UP0   = al256(WS_XC + (size_t)MC * D * 4);
constexpr size_t WS_DN0   = WS_UP0 + 2 * SZ_UP;
constexpr size_t WS_WIN   = WS_DN0 + 2 * SZ_DN;
constexpr size_t WS_WOUT  = WS_WIN + (size_t)DIN * D * 2;
constexpr size_t WS_GIN   = WS_WOUT + (size_t)D * D * 2;
constexpr size_t WS_GOUT  = WS_GIN + (size_t)2 * D * D * 2;
constexpr size_t WS_WS    = WS_GOUT + (size_t)D * D * 2;
constexpr size_t WS_H     = al256(WS_WS + (size_t)8 * 128 * 128 * 2);
constexpr size_t WS_R     = al256(WS_H + (size_t)MT * D * 2);
constexpr size_t R_G      = 0;
constexpr size_t R_UP1    = al256((size_t)MT * DFF * 2 + 4096);
constexpr size_t R_DN1    = R_UP1 + 2 * SZ_UP;
constexpr size_t R_FFN_END = R_DN1 + 2 * SZ_DN;
constexpr size_t R_PART   = R_UP1;
constexpr size_t R_PP     = 0;
constexpr size_t R_Q      = al256(R_PP + (size_t)MT * 256 * 4);
constexpr size_t R_V      = al256(R_Q + (size_t)MT * DH * 2);
constexpr size_t R_GT     = al256(R_V + (size_t)MT * DH * 2);
constexpr size_t R_LF     = al256(R_GT + (size_t)MT * DH * 2);
constexpr size_t R_DS     = al256(R_LF + (size_t)2 * MT * DH * 2);
constexpr size_t R_DEC    = al256(R_DS + (size_t)1536 * 16384 * 2);
constexpr size_t R_AB_END = al256(R_DEC + (size_t)1536 * 128 * 4);
constexpr size_t R_U      = 0;
constexpr size_t R_VG     = (size_t)ML * D * 2;
constexpr size_t R_SIZE   = R_AB_END > R_FFN_END ? R_AB_END : R_FFN_END;
constexpr size_t WS_END   = WS_R + R_SIZE;

struct Args {
    const float* in[23]; float* out; unsigned char* ws; int ph_lo, ph_hi;
};

struct Frame {
    LAS unsigned char* lds; int tid, lane, wid, G, bid;
    float* out; unsigned char* ws;
};

__device__ __forceinline__ float bf_lo(unsigned w) { return __uint_as_float(w << 16); }
__device__ __forceinline__ float bf_hi(unsigned w) { return __uint_as_float(w & 0xffff0000u); }
__device__ __forceinline__ float fast_rcp(float x) { return __builtin_amdgcn_rcpf(x); }
__device__ __forceinline__ float sigmoidf_(float x) { return fast_rcp(1.0f + __expf(-x)); }
__device__ __forceinline__ float siluf_(float x) { return x * sigmoidf_(x); }
__device__ __forceinline__ float gelu_tanh(float x) { const float u = 0.7978845608f * (x + 0.044715f * x * x * x); return x * sigmoidf_(2.0f * u); }
__device__ __forceinline__ f32x4 mfma16(bf16x8 a, bf16x8 b, f32x4 c) { return __builtin_amdgcn_mfma_f32_16x16x32_bf16(a, b, c, 0, 0, 0); }

struct EpiSwiGlu {
    static constexpr bool PERM = true, AFTER_DRAIN = false;
    bf16_t* G;
    __device__ __forceinline__ void operator()(const f32x4 (&acc)[2][2][4][2], const Unit& u, int wr, int wc, int fr, int fq) const {
        const int row0 = u.pm * 256 + wr * 64 + fr, col0 = u.pn * 128 + wc * 32 + 8 * fq;
#pragma unroll
        for (int ai = 0; ai < 2; ++ai)
#pragma unroll
            for (int m = 0; m < 4; ++m) {
                bf16_t* p = G + (size_t)(row0 + ai * 128 + m * 16) * DFF + col0;
                const f32x4 a0 = acc[ai][0][m][0], a1 = acc[ai][0][m][1], b0 = acc[ai][1][m][0], b1 = acc[ai][1][m][1];
                u32x4 w;
                w.x = cvt_pk_bf16(siluf_(a0[0]) * b0[0], siluf_(a0[1]) * b0[1]); w.y = cvt_pk_bf16(siluf_(a0[2]) * b0[2], siluf_(a0[3]) * b0[3]);
                w.z = cvt_pk_bf16(siluf_(a1[0]) * b1[0], siluf_(a1[1]) * b1[1]); w.w = cvt_pk_bf16(siluf_(a1[2]) * b1[2], siluf_(a1[3]) * b1[3]);
                *(u32x4*)p = w;
            }
    }
};
struct EpiResid {
    static constexpr bool PERM = false, AFTER_DRAIN = false;
    const float* baseL; const float* baseC; float* outL; float* outC; const float* gate  ; float scale;
    __device__ __forceinline__ void operator()(const f32x4 (&acc)[2][2][4][2], const Unit& u, int wr, int wc, int fr, int fq) const {
        const bool isc = u.pm >= 64; const int vec = isc ? 2 : (u.pm >> 5);
        const int row0 = (isc ? (u.pm - 64) * 256 : u.pm * 256) + wr * 64 + fr, col0 = u.pn * 256 + wc * 32 + 4 * fq;
        const float* base = isc ? baseC : baseL; float* out = isc ? outC : outL;
        f32x4 gv[4];
#pragma unroll
        for (int g = 0; g < 4; ++g) gv[g] = *(const f32x4*)(gate + (size_t)vec * NMODD + col0 + (g >> 1) * 128 + (g & 1) * 16) * scale;
        f32x4 A[4], B[4];
#pragma unroll
        for (int m = 0; m < 4; ++m) A[m] = *(const f32x4*)(base + (size_t)(row0 + m * 16) * D + col0);
#pragma unroll
        for (int step = 0; step < 8; ++step) {
            const int g = step >> 1, hh = step & 1, bj = g >> 1, n = g & 1, cg = col0 + bj * 128 + n * 16;
            if (step < 7) { const int s2 = step + 1, g2 = s2 >> 1, h2 = s2 & 1, cn = col0 + (g2 >> 1) * 128 + (g2 & 1) * 16;
#pragma unroll
                for (int m = 0; m < 4; ++m) { const f32x4 t = *(const f32x4*)(base + (size_t)(row0 + h2 * 128 + m * 16) * D + cn); if (step & 1) A[m] = t; else B[m] = t; } }
            __builtin_amdgcn_sched_barrier(0);
#pragma unroll
            for (int m = 0; m < 4; ++m) *(f32x4*)(out + (size_t)(row0 + hh * 128 + m * 16) * D + cg) = ((step & 1) ? B[m] : A[m]) + gv[g] * acc[hh][bj][m][n];
            __builtin_amdgcn_sched_barrier(0);
        }
    }
};
struct EpiWin {
    static constexpr bool PERM = true, AFTER_DRAIN = false;
    unsigned char* R  ; const float* lb  ;
    __device__ __forceinline__ void operator()(const f32x4 (&acc)[2][2][4][2], const Unit& u, int wr, int wc, int fr, int fq) const {
        const int row0 = u.pm * 256 + wr * 64 + fr, cw = wc * 32 + 8 * fq;
        const int pn = u.pn;
        if (pn == 0) {
#pragma unroll
            for (int ai = 0; ai < 2; ++ai)
#pragma unroll
                for (int m = 0; m < 4; ++m) { float* p = (float*)(R + R_PP) + (size_t)(row0 + ai * 128 + m * 16) * 256 + cw;
#pragma unroll
                    for (int bj = 0; bj < 2; ++bj) { *(f32x4*)(p + bj * 128) = acc[ai][bj][m][0]; *(f32x4*)(p + bj * 128 + 4) = acc[ai][bj][m][1]; } }
            return;
        }
        const int sec = (pn - 1) / 3, scol = ((pn - 1) % 3) * 256 + cw;
        if (sec == 2 || sec == 3) {
            const int dir = sec - 2; _Float16* O = (_Float16*)(R + R_LF) + (size_t)dir * MT * DH;
#pragma unroll
            for (int bj = 0; bj < 2; ++bj) {
                float lbv[8];
#pragma unroll
                for (int e = 0; e < 8; ++e) { const int c = scol + bj * 128 + e; const float l0 = lb[dir * DH + c], l1 = lb[2 * DH + dir * DH + c]; lbv[e] = fast_rcp(1.0f + __expf(l1 - l0)); }
#pragma unroll
                for (int ai = 0; ai < 2; ++ai)
#pragma unroll
                    for (int m = 0; m < 4; ++m) { _Float16* p = O + (size_t)(row0 + ai * 128 + m * 16) * DH + scol; f16x8 w;
#pragma unroll
                        for (int e = 0; e < 8; ++e) { const float a = acc[ai][bj][m][e >> 2][e & 3]; const float l = lbv[e]; w[e] = (_Float16)fminf((1.0f - l) * fast_rcp(1.0f + __expf(a)), 0.9995f); }
                        *(f16x8*)(p + bj * 128) = w; }
                __builtin_amdgcn_sched_barrier(0);
            }
            return;
        }
        const size_t ooff = sec == 0 ? R_Q : (sec == 1 ? R_V : R_GT); bf16_t* O = (bf16_t*)(R + ooff);
#pragma unroll
        for (int ai = 0; ai < 2; ++ai)
#pragma unroll
            for (int m = 0; m < 4; ++m) { bf16_t* p = O + (size_t)(row0 + ai * 128 + m * 16) * DH + scol;
#pragma unroll
                for (int bj = 0; bj < 2; ++bj) { float v[8];
#pragma unroll
                    for (int e = 0; e < 8; ++e) { const float a = acc[ai][bj][m][e >> 2][e & 3]; v[e] = sec == 0 ? siluf_(a) * 0.08838834764831845f : (sec == 1 ? a : siluf_(a)); }
                    u32x4 w; w.x = cvt_pk_bf16(v[0], v[1]); w.y = cvt_pk_bf16(v[2], v[3]); w.z = cvt_pk_bf16(v[4], v[5]); w.w = cvt_pk_bf16(v[6], v[7]);
                    *(u32x4*)(p + bj * 128) = w; } }
    }
};
struct EpiGin {
    static constexpr bool PERM = true, AFTER_DRAIN = false;
    bf16_t* U; bf16_t* VG;
    __device__ __forceinline__ void operator()(const f32x4 (&acc)[2][2][4][2], const Unit& u, int wr, int wc, int fr, int fq) const {
        const int row0 = u.pm * 256 + wr * 64 + fr; bf16_t* O = u.pn < 4 ? U : VG; const int col0 = (u.pn & 3) * 256 + wc * 32 + 8 * fq;
#pragma unroll
        for (int ai = 0; ai < 2; ++ai)
#pragma unroll
            for (int m = 0; m < 4; ++m) { bf16_t* p = O + (size_t)(row0 + ai * 128 + m * 16) * D + col0;
#pragma unroll
                for (int bj = 0; bj < 2; ++bj) { const f32x4 a0 = acc[ai][bj][m][0], a1 = acc[ai][bj][m][1]; u32x4 w;
                    w.x = cvt_pk_bf16(gelu_tanh(a0[0]), gelu_tanh(a0[1])); w.y = cvt_pk_bf16(gelu_tanh(a0[2]), gelu_tanh(a0[3]));
                    w.z = cvt_pk_bf16(gelu_tanh(a1[0]), gelu_tanh(a1[1])); w.w = cvt_pk_bf16(gelu_tanh(a1[2]), gelu_tanh(a1[3]));
                    *(u32x4*)(p + bj * 128) = w; } }
    }
};

template <class Epi>
__device__ __forceinline__ void run_gemm(const Frame& F, const bf16_t* A, const bf16_t* Bt, int M, int N, int K, const Epi& E) {
    pg8::StaticOrder S; S.init(M, N, F.G, F.bid);
    pg8::Gemm g; g.A = A; g.Bt = Bt; g.M = M; g.N = N; g.K = K; g.ld = K;
    pg8::gemm_phase<Epi, pg8::StaticOrder, false>(F.lds, g, S, E, nullptr);
    __syncthreads();
}

struct OneUnit {
    int pm, pn; bool on;
    __device__ bool next(int i, Unit& u) const { if (i != 0 || !on) return false; u.pm = pm; u.pn = pn; return true; }
    __device__ __forceinline__ void a_ready(const Unit&) const {}
    __device__ __forceinline__ void done(const Unit&) const {}
};
struct EpiPartCtx {
    static constexpr bool PERM = false, AFTER_DRAIN = false;
    float* part;
    __device__ __forceinline__ void operator()(const f32x4 (&acc)[2][2][4][2], const Unit& u, int wr, int wc, int fr, int fq) const {
        const int row0 = u.pm * 256 + wr * 64 + fr, col0 = u.pn * 256 + wc * 32 + 4 * fq;
#pragma unroll
        for (int ai = 0; ai < 2; ++ai)
#pragma unroll
            for (int m = 0; m < 4; ++m) { float* p = part + (size_t)(row0 + ai * 128 + m * 16) * D + col0;
#pragma unroll
                for (int bj = 0; bj < 2; ++bj)
#pragma unroll
                    for (int n = 0; n < 2; ++n) *(f32x4*)(p + bj * 128 + n * 16) = acc[ai][bj][m][n]; }
    }
};
__device__ __forceinline__ void run_ctx_down_splitk(const Frame& F, const bf16_t* Gctx  , const bf16_t* Bt, float* part) {
    const int ks = F.bid % 11, tile = F.bid / 11;
    OneUnit S; S.on = F.bid < 88; S.pm = tile >> 2; S.pn = tile & 3;
    pg8::Gemm g; g.A = Gctx + ks * 256; g.Bt = Bt + ks * 256; g.M = MC; g.N = D; g.K = 256; g.ld = DFF;
    EpiPartCtx E; E.part = part + (size_t)ks * MC * D;
    pg8::gemm_phase<EpiPartCtx, OneUnit, false>(F.lds, g, S, E, nullptr);
    __syncthreads();
}

__device__ __forceinline__ void transpose_tile(const Frame& F, const float* W, bf16_t* Bt, int K, int N, int mode, int tile) {
    LAS float* T = (LAS float*)F.lds;
    const int ntn = N >> 8, tk = tile / ntn, tn = tile % ntn, k0 = tk * 64, n0 = tn * 256;
    const int tid = F.tid;
    __syncthreads();
    f32x4 v[8];
#pragma unroll
    for (int i = 0; i < 8; ++i) { const int id = tid + NTHR * i, r = id >> 6, c4 = (id & 63) * 4; v[i] = __builtin_nontemporal_load((const f32x4*)(W + (size_t)(k0 + r) * N + n0 + c4)); }
#pragma unroll
    for (int i = 0; i < 8; ++i) { const int id = tid + NTHR * i, r = id >> 6, c4 = (id & 63) * 4; LAS float* p = T + r * 257 + c4; p[0] = v[i][0]; p[1] = v[i][1]; p[2] = v[i][2]; p[3] = v[i][3]; }
    __syncthreads();
#pragma unroll
    for (int j = 0; j < 4; ++j) { const int id = tid + NTHR * j, nl = id >> 3, k8 = (id & 7) * 8;
        const float v0 = T[(k8 + 0) * 257 + nl], v1 = T[(k8 + 1) * 257 + nl], v2 = T[(k8 + 2) * 257 + nl], v3 = T[(k8 + 3) * 257 + nl], v4 = T[(k8 + 4) * 257 + nl], v5 = T[(k8 + 5) * 257 + nl], v6 = T[(k8 + 6) * 257 + nl], v7 = T[(k8 + 7) * 257 + nl];
        const int n = n0 + nl; const int row = mode == 0 ? n : ((n >> 7) * 256 + (n & 127) + (mode == 2 ? 128 : 0));
        u32x4 w; w.x = cvt_pk_bf16(v0, v1); w.y = cvt_pk_bf16(v2, v3); w.z = cvt_pk_bf16(v4, v5); w.w = cvt_pk_bf16(v6, v7);
        *(u32x4*)(Bt + (size_t)row * K + k0 + k8) = w; }
}
__device__ __forceinline__ void do_tjob(const Frame& F, const Args& A, int set, int i, int tile) {
    const int layer = set;
    unsigned char* upb = set == 0 ? F.ws + WS_UP0 : F.ws + WS_R + R_UP1; unsigned char* dnb = set == 0 ? F.ws + WS_DN0 : F.ws + WS_R + R_DN1;
    const float* W; bf16_t* Bt; int K, N, mode;
    if (i < 4) { const int f = i >> 1, which = i & 1; W = (which ? A.in[8] : A.in[7]) + (size_t)(layer * 2 + f) * D * DFF; Bt = (bf16_t*)(upb + (size_t)f * SZ_UP); K = D; N = DFF; mode = 1 + which; }
    else if (i < 6) { const int f = i - 4; W = A.in[9] + (size_t)(layer * 2 + f) * DFF * D; Bt = (bf16_t*)(dnb + (size_t)f * SZ_DN); K = DFF; N = D; mode = 0; }
    else if (i == 6) { W = A.in[10]; Bt = (bf16_t*)(F.ws + WS_WIN); K = D; N = DIN; mode = 0; }
    else if (i == 7) { W = A.in[15]; Bt = (bf16_t*)(F.ws + WS_WOUT); K = D; N = D; mode = 0; }
    else if (i == 8) { W = A.in[16]; Bt = (bf16_t*)(F.ws + WS_GIN); K = D; N = 2 * D; mode = 0; }
    else { W = A.in[21]; Bt = (bf16_t*)(F.ws + WS_GOUT); K = D; N = D; mode = 0; }
    transpose_tile(F, W, Bt, K, N, mode, tile);
}
__device__ __forceinline__ int tjob_tiles(int i) { return i < 6 ? 176 : (i == 6 ? 256 : (i == 8 ? 128 : 64)); }
__device__ __forceinline__ void run_tjobs(const Frame& F, const Args& A, int set, unsigned jobmask, int first_wg, int n_wgs) {
    const int nj = set == 0 ? 10 : 6;
    if (F.bid >= first_wg && F.bid < first_wg + n_wgs) {
        int total = 0;
        for (int i = 0; i < nj; ++i) if ((jobmask >> i) & 1u) total += tjob_tiles(i);
        for (int t = F.bid - first_wg; t < total; t += n_wgs) {
            int rem = t, ji = 0; bool found = false;
            for (int i = 0; i < nj; ++i) if (((jobmask >> i) & 1u) && !found) { const int cnt = tjob_tiles(i); if (rem < cnt) { ji = i; found = true; } else rem -= cnt; }
            do_tjob(F, A, set, ji, rem);
        }
    }
    __syncthreads();
}


__device__ __forceinline__ void mod_phase(const Frame& F, const float* c_in, const float* c_ctx, const float* mod_w, const float* mod_b, const float* w_s) {
    LAS float* SC = (LAS float*)F.lds;
    LAS float* RED = (LAS float*)(F.lds + 3 * 1024 * 4);
    const int tid = F.tid;
    __syncthreads();
    for (int i = tid; i < 3 * 1024; i += NTHR) { const int v = i >> 10, k = i & 1023; const float c = v < 2 ? c_in[v * 1024 + k] : c_ctx[k]; SC[i] = siluf_(c); }
    __syncthreads();
    float* MOD = (float*)(F.ws + WS_MOD);
    const int cg4 = tid & 7, ks = tid >> 3;
    for (int item = F.bid; item < 2 * 288; item += F.G) {
        const int l = item / 288, n0 = (item % 288) * 32;
        const float* W = mod_w + (size_t)l * D * NMODD + n0 + cg4 * 4;
        f32x4 a0 = {0.f, 0.f, 0.f, 0.f}, a1 = a0, a2 = a0;
#pragma unroll 8
        for (int r = 0; r < 16; ++r) { const int k = ks * 16 + r; const f32x4 w = __builtin_nontemporal_load((const f32x4*)(W + (size_t)k * NMODD)); a0 += w * SC[k]; a1 += w * SC[1024 + k]; a2 += w * SC[2048 + k]; }
        __syncthreads();
        *(LAS f32x4*)(RED + (ks * 3 + 0) * 32 + cg4 * 4) = a0; *(LAS f32x4*)(RED + (ks * 3 + 1) * 32 + cg4 * 4) = a1; *(LAS f32x4*)(RED + (ks * 3 + 2) * 32 + cg4 * 4) = a2;
        __syncthreads();
        if (tid < 96) { const int v = tid >> 5, c = tid & 31; float s = 0.f;
            for (int k2 = 0; k2 < 64; ++k2) s += RED[(k2 * 3 + v) * 32 + c];
            MOD[(size_t)(l * 3 + v) * NMODD + n0 + c] = s + mod_b[(size_t)l * NMODD + n0 + c]; }
    }
    __syncthreads();
    bf16_t* WSB = (bf16_t*)(F.ws + WS_WS);
    for (int i = (F.bid * NTHR + tid) * 2; i < 8 * 128 * 128; i += F.G * NTHR * 2) { const f32x2 v = *(const f32x2*)(w_s + i); *(unsigned*)(WSB + i) = cvt_pk_bf16(v.x, v.y); }
}

__device__ __forceinline__ void norm_phase(const Frame& F, const float* xl, const float* xc, int nrows, const float* g, const float* modl, int s, bf16_t* H, const float* part = nullptr, const float* pgate = nullptr) {
    const int lane = F.lane, stride = F.G * 8;
    for (int row0 = F.bid * 8 + F.wid; row0 < nrows; row0 += 2 * stride) {
        f32x4 v[2][4]; float ss[2];
#pragma unroll
        for (int t = 0; t < 2; ++t) { const int row = row0 + t * stride; const bool ok = row < nrows; const int rr = ok ? row : row0;
            const float* src = rr < ML ? xl + (size_t)rr * D : xc + (size_t)(rr - ML) * D;
#pragma unroll
            for (int i = 0; i < 4; ++i) v[t][i] = *(const f32x4*)(src + i * 256 + lane * 4);
            if (part != nullptr && rr >= ML) {
#pragma unroll
                for (int i = 0; i < 4; ++i) { f32x4 a = {0.f, 0.f, 0.f, 0.f};
#pragma unroll
                    for (int ks = 0; ks < 11; ++ks) a += *(const f32x4*)(part + ((size_t)ks * MC + (rr - ML)) * D + i * 256 + lane * 4);
                    v[t][i] += a * (*(const f32x4*)(pgate + i * 256 + lane * 4) * 0.5f); } }
        }
#pragma unroll
        for (int t = 0; t < 2; ++t) { float q = 0.f;
#pragma unroll
            for (int i = 0; i < 4; ++i) q += v[t][i][0] * v[t][i][0] + v[t][i][1] * v[t][i][1] + v[t][i][2] * v[t][i][2] + v[t][i][3] * v[t][i][3];
#pragma unroll
            for (int o = 32; o >= 1; o >>= 1) q += __shfl_xor(q, o);
            ss[t] = q; }
#pragma unroll
        for (int t = 0; t < 2; ++t) { const int row = row0 + t * stride; if (row < nrows) {
            const int vec = row < 8192 ? 0 : (row < ML ? 1 : 2);
            const float rstd = 1.0f / sqrtf(ss[t] * (1.0f / D) + EPS);
            const float* sc = modl + (size_t)vec * NMODD + (3 * s + 1) * 1024; const float* sh = modl + (size_t)vec * NMODD + (3 * s) * 1024;
            f32x4 gg[4], s4[4], h4[4];
#pragma unroll
            for (int i = 0; i < 4; ++i) { const int c = i * 256 + lane * 4; gg[i] = *(const f32x4*)(g + c); s4[i] = *(const f32x4*)(sc + c); h4[i] = *(const f32x4*)(sh + c); }
#pragma unroll
            for (int i = 0; i < 4; ++i) { const int c = i * 256 + lane * 4;
                const f32x4 y = (v[t][i] * rstd) * gg[i] * (s4[i] + 1.0f) + h4[i]; u32x2 w; w.x = cvt_pk_bf16(y[0], y[1]); w.y = cvt_pk_bf16(y[2], y[3]); *(u32x2*)(H + (size_t)row * D + c) = w; } } }
    }
}
__device__ __forceinline__ void final_norm_phase(const Frame& F, float* x, const float* g) {
    const int lane = F.lane, stride = F.G * 8;
    f32x4 gg[4];
#pragma unroll
    for (int i = 0; i < 4; ++i) gg[i] = *(const f32x4*)(g + i * 256 + lane * 4);
    for (int row0 = F.bid * 8 + F.wid; row0 < ML; row0 += 2 * stride) {
        f32x4 v[2][4];
#pragma unroll
        for (int t = 0; t < 2; ++t) { const int row = row0 + t * stride; const int rr = row < ML ? row : row0;
#pragma unroll
            for (int i = 0; i < 4; ++i) v[t][i] = *(const f32x4*)(x + (size_t)rr * D + i * 256 + lane * 4); }
#pragma unroll
        for (int t = 0; t < 2; ++t) { const int row = row0 + t * stride; float q = 0.f;
#pragma unroll
            for (int i = 0; i < 4; ++i) q += v[t][i][0] * v[t][i][0] + v[t][i][1] * v[t][i][1] + v[t][i][2] * v[t][i][2] + v[t][i][3] * v[t][i][3];
#pragma unroll
            for (int o = 32; o >= 1; o >>= 1) q += __shfl_xor(q, o);
            const float rstd = 1.0f / sqrtf(q * (1.0f / D) + EPS);
            if (row < ML) {
#pragma unroll
                for (int i = 0; i < 4; ++i) { const int c = i * 256 + lane * 4; *(f32x4*)(x + (size_t)row * D + c) = (v[t][i] * rstd) * gg[i]; } } }
    }
}

constexpr int RS128 = 136, RS64 = 72;
constexpr int QE_OFF = 0, KE_OFF = 17408, QD_OFF = 34816, KDT_OFF = 52224, VT_OFF = 70656, AL_OFF = 89088, ST_OFF = 98304, TOT_OFF = 133120, BL_OFF = 137216, RED_OFF = 137728;

struct ScanPre { unsigned lf[8], v[8], q[8]; };
template <bool OUT>
__device__ __forceinline__ void scan_load(const Frame& F, ScanPre& P, const bf16_t* Qg, const bf16_t* Vg, const _Float16* LFg, int row0, int hcol) {
    const int c0 = hcol + 2 * F.lane;
#pragma unroll
    for (int i = 0; i < 8; ++i) { const size_t ro = (size_t)(row0 + 8 * F.wid + i) * DH + c0; P.lf[i] = *(const unsigned*)(LFg + ro); P.v[i] = *(const unsigned*)(Vg + ro); P.q[i] = OUT ? *(const unsigned*)(Qg + ro) : 0u; }
}
template <bool OUT>
__device__ __forceinline__ void scan_chunk(const Frame& F, const ScanPre& P, ScanPre& N, bool has_next, const bf16_t* Qg, const bf16_t* Vg, const _Float16* nLFg, int nrow0, int nhcol, bool rev, f32x4 (&Sacc)[8], f32x4 (&oacc)[4], float& ld0, float& ld1) {
    LAS unsigned char* lds = F.lds; const int wid = F.wid, lane = F.lane, r = lane & 15, q = lane >> 4;
    LAS float* TOT = (LAS float*)(lds + TOT_OFF); LAS float* BL = (LAS float*)(lds + BL_OFF);
    float c_0[8], c_1[8], lf0[8], lf1[8]; unsigned qv[8], vv[8];
    float kk0[8], kk1[8];
#pragma unroll
    for (int i = 0; i < 8; ++i) { const f16x2 h = __builtin_bit_cast(f16x2, P.lf[i]); kk0[i] = (float)h.x; kk1[i] = (float)h.y; lf0[i] = __logf(1.0f - kk0[i]); lf1[i] = __logf(1.0f - kk1[i]); vv[i] = P.v[i]; qv[i] = P.q[i]; }
    float t0 = 0.f, t1 = 0.f;
    if (!rev) {
#pragma unroll
        for (int i = 0; i < 8; ++i) { t0 += lf0[i]; t1 += lf1[i]; c_0[i] = t0; c_1[i] = t1; }
    } else {
#pragma unroll
        for (int i = 7; i >= 0; --i) { t0 += lf0[i]; t1 += lf1[i]; c_0[i] = t0; c_1[i] = t1; }
    }
    *(LAS f32x2*)(TOT + wid * 128 + 2 * lane) = (f32x2){t0, t1};
    __syncthreads();
    __builtin_amdgcn_sched_barrier(0);
    float off0 = 0.f, off1 = 0.f, mid0 = 0.f, mid1 = 0.f, last0 = 0.f, last1 = 0.f;
#pragma unroll
    for (int w = 0; w < 8; ++w) { const f32x2 t = *(LAS f32x2*)(TOT + w * 128 + 2 * lane); last0 += t.x; last1 += t.y;
        const bool before = rev ? (w > wid) : (w < wid); if (before) { off0 += t.x; off1 += t.y; }
        const bool inmid = rev ? (w >= 4) : (w < 4); if (inmid) { mid0 += t.x; mid1 += t.y; } }
    if (wid == 0) *(LAS f32x2*)(BL + 2 * lane) = (f32x2){last0, last1};
    ld0 += last0; ld1 += last1;
    unsigned kd0p[4], kd1p[4];
    {
        float kd0[8], kd1[8];
#pragma unroll
        for (int i = 0; i < 8; ++i) {
            const float b0 = off0 + c_0[i], b1 = off1 + c_1[i];
            const float k0 = kk0[i], k1 = kk1[i];
            kd0[i] = k0 * __expf(last0 - b0); kd1[i] = k1 * __expf(last1 - b1);
            if (OUT) {
                const float q0 = bf_lo(qv[i]), q1 = bf_hi(qv[i]); const int j = 8 * wid + i;
                *(LAS unsigned*)(lds + QE_OFF + (j * RS128 + 2 * lane) * 2) = cvt_pk_bf16(q0 * __expf(b0 - mid0), q1 * __expf(b1 - mid1));
                *(LAS unsigned*)(lds + KE_OFF + (j * RS128 + 2 * lane) * 2) = cvt_pk_bf16(k0 * __expf(mid0 - b0), k1 * __expf(mid1 - b1));
                *(LAS unsigned*)(lds + QD_OFF + (j * RS128 + 2 * lane) * 2) = cvt_pk_bf16(q0 * __expf(b0), q1 * __expf(b1));
            }
        }
#pragma unroll
        for (int k = 0; k < 4; ++k) { kd0p[k] = cvt_pk_bf16(kd0[2 * k], kd0[2 * k + 1]); kd1p[k] = cvt_pk_bf16(kd1[2 * k], kd1[2 * k + 1]); }
    }
    *(LAS u32x4*)(lds + KDT_OFF + ((2 * lane) * RS64 + 8 * wid) * 2) = (u32x4){kd0p[0], kd0p[1], kd0p[2], kd0p[3]};
    *(LAS u32x4*)(lds + KDT_OFF + ((2 * lane + 1) * RS64 + 8 * wid) * 2) = (u32x4){kd1p[0], kd1p[1], kd1p[2], kd1p[3]};
    {
        u32x4 a, b;
        a.x = (vv[0] & 0xffffu) | (vv[1] << 16); a.y = (vv[2] & 0xffffu) | (vv[3] << 16); a.z = (vv[4] & 0xffffu) | (vv[5] << 16); a.w = (vv[6] & 0xffffu) | (vv[7] << 16);
        b.x = (vv[0] >> 16) | (vv[1] & 0xffff0000u); b.y = (vv[2] >> 16) | (vv[3] & 0xffff0000u); b.z = (vv[4] >> 16) | (vv[5] & 0xffff0000u); b.w = (vv[6] >> 16) | (vv[7] & 0xffff0000u);
        *(LAS u32x4*)(lds + VT_OFF + ((2 * lane) * RS64 + 8 * wid) * 2) = a;
        *(LAS u32x4*)(lds + VT_OFF + ((2 * lane + 1) * RS64 + 8 * wid) * 2) = b;
    }
    if (has_next) scan_load<OUT>(F, N, Qg, Vg, nLFg, nrow0, nhcol);
    __syncthreads();
    __builtin_amdgcn_sched_barrier(0);
    if (OUT) {
        const int jt = wid >> 1;
#pragma unroll
        for (int x = 0; x < 2; ++x) {
            const int it = (wid & 1) * 2 + x; f32x4 a = {0.f, 0.f, 0.f, 0.f};
            const bool dead = rev ? (it < jt) : (it > jt);
            if (!dead) {
#pragma unroll
                for (int kt = 0; kt < 4; ++kt) { const bf16x8 P = *(const LAS bf16x8*)(lds + KE_OFF + ((it * 16 + r) * RS128 + kt * 32 + 8 * q) * 2), Qf = *(const LAS bf16x8*)(lds + QE_OFF + ((jt * 16 + r) * RS128 + kt * 32 + 8 * q) * 2);
                    a = mfma16(P, Qf, a); }
            }
            const int j = jt * 16 + r;
#pragma unroll
            for (int e = 0; e < 4; ++e) { const int i = it * 16 + 4 * q + e; const bool keep = rev ? (i >= j) : (i <= j); if (!keep) a[e] = 0.f; }
            *(LAS u32x2*)(lds + AL_OFF + (j * RS64 + it * 16 + 4 * q) * 2) = (u32x2){cvt_pk_bf16(a[0], a[1]), cvt_pk_bf16(a[2], a[3])};
            __builtin_amdgcn_sched_barrier(0);
        }
        __syncthreads();
    }
    bf16x8 Pvt[2];
#pragma unroll
    for (int kt = 0; kt < 2; ++kt) Pvt[kt] = *(const LAS bf16x8*)(lds + VT_OFF + ((16 * wid + r) * RS64 + kt * 32 + 8 * q) * 2);
    if (OUT) {
        bf16x8 Pst[4];
#pragma unroll
        for (int kt = 0; kt < 4; ++kt) Pst[kt] = *(const LAS bf16x8*)(lds + ST_OFF + ((16 * wid + r) * RS128 + kt * 32 + 8 * q) * 2);
#pragma unroll
        for (int jt2 = 0; jt2 < 4; ++jt2) {
            bf16x8 Qd[4], Qa[2];
#pragma unroll
            for (int kt = 0; kt < 4; ++kt) Qd[kt] = *(const LAS bf16x8*)(lds + QD_OFF + ((jt2 * 16 + r) * RS128 + kt * 32 + 8 * q) * 2);
#pragma unroll
            for (int kt = 0; kt < 2; ++kt) Qa[kt] = *(const LAS bf16x8*)(lds + AL_OFF + ((jt2 * 16 + r) * RS64 + kt * 32 + 8 * q) * 2);
            f32x4 o = oacc[jt2];
#pragma unroll
            for (int kt = 0; kt < 4; ++kt) o = mfma16(Pst[kt], Qd[kt], o);
#pragma unroll
            for (int kt = 0; kt < 2; ++kt) o = mfma16(Pvt[kt], Qa[kt], o);
            oacc[jt2] = o;
            if (jt2 == 1) __builtin_amdgcn_sched_barrier(0);
        }
    }
#pragma unroll
    for (int dt = 0; dt < 8; ++dt) {
        const f32x4 bl = *(const LAS f32x4*)(BL + 16 * dt + 4 * q);
        bf16x8 Pk[2];
#pragma unroll
        for (int kt = 0; kt < 2; ++kt) Pk[kt] = *(const LAS bf16x8*)(lds + KDT_OFF + ((16 * dt + r) * RS64 + kt * 32 + 8 * q) * 2);
        f32x4 s = Sacc[dt]; s[0] *= __expf(bl[0]); s[1] *= __expf(bl[1]); s[2] *= __expf(bl[2]); s[3] *= __expf(bl[3]);
#pragma unroll
        for (int kt = 0; kt < 2; ++kt) s = mfma16(Pk[kt], Pvt[kt], s);
        Sacc[dt] = s;
        if (OUT) *(LAS u32x2*)(lds + ST_OFF + ((16 * wid + r) * RS128 + 16 * dt + 4 * q) * 2) = (u32x2){cvt_pk_bf16(s[0], s[1]), cvt_pk_bf16(s[2], s[3])};
        if ((dt & 3) == 3) __builtin_amdgcn_sched_barrier(0);
    }
}

__device__ __forceinline__ void scan_pass1(const Frame& F) {
    const bf16_t* Vg = (const bf16_t*)(F.ws + WS_R + R_V); const _Float16* LF = (const _Float16*)(F.ws + WS_R + R_LF);
    bf16_t* DS = (bf16_t*)(F.ws + WS_R + R_DS); float* DEC = (float*)(F.ws + WS_R + R_DEC);
    const int wid = F.wid, lane = F.lane, r = lane & 15, q = lane >> 4;
    int item = F.bid, cc = 0;
    ScanPre pre, nxt;
    int chain = item >> 6, n = ((item & 63) + 7 * chain) & 63, dir = chain & 1, bh = chain >> 1, b = bh / 6, h = bh % 6, nch = n == 0 ? 4 : 2;
    int rowbase = n == 0 ? ML + b * 256 : b * 8192 + (dir ? 63 - (n - 1) : (n - 1)) * 128;
    if (item < 24 * 64) scan_load<false>(F, pre, nullptr, Vg, LF + (size_t)dir * MT * DH, rowbase + 64 * (dir ? nch - 1 : 0), h * 128);
    f32x4 Sacc[8], odum[4]; float ld0 = 0.f, ld1 = 0.f;
#pragma unroll 1
    while (item < 24 * 64) {
        int item2 = item, cc2 = cc + 1; if (cc2 == nch) { cc2 = 0; item2 = item + F.G; }
        const bool has_next = item2 < 24 * 64;
        const int chain2 = item2 >> 6, n2 = ((item2 & 63) + 7 * chain2) & 63, dir2 = chain2 & 1, bh2 = chain2 >> 1, b2 = bh2 / 6, h2 = bh2 % 6, nch2 = n2 == 0 ? 4 : 2;
        const int rowbase2 = n2 == 0 ? ML + b2 * 256 : b2 * 8192 + (dir2 ? 63 - (n2 - 1) : (n2 - 1)) * 128;
        const int c2 = dir2 ? nch2 - 1 - cc2 : cc2;
        if (cc == 0) {
#pragma unroll
            for (int i = 0; i < 8; ++i) Sacc[i] = (f32x4){0.f, 0.f, 0.f, 0.f};
            ld0 = 0.f; ld1 = 0.f;
        }
        scan_chunk<false>(F, pre, nxt, has_next, nullptr, Vg, LF + (size_t)dir2 * MT * DH, rowbase2 + 64 * c2, h2 * 128, dir != 0, Sacc, odum, ld0, ld1);
        if (cc == nch - 1) {
            const int sid = (item >> 6) * 64 + (((item & 63) + 7 * (item >> 6)) & 63);
            bf16_t* slot = DS + (size_t)sid * 16384;
#pragma unroll
            for (int dt = 0; dt < 8; ++dt) *(u32x2*)(slot + (16 * wid + r) * 128 + 16 * dt + 4 * q) = (u32x2){cvt_pk_bf16(Sacc[dt][0], Sacc[dt][1]), cvt_pk_bf16(Sacc[dt][2], Sacc[dt][3])};
            if (wid == 0) *(f32x2*)(DEC + (size_t)sid * 128 + 2 * lane) = (f32x2){__expf(ld0), __expf(ld1)};
        }
        pre = nxt; item = item2; cc = cc2; dir = dir2; nch = nch2;
    }
    __syncthreads();
}
__device__ __forceinline__ void scan_pass2(const Frame& F) {
    bf16_t* DS = (bf16_t*)(F.ws + WS_R + R_DS); const float* DEC = (const float*)(F.ws + WS_R + R_DEC);
    for (int idx = F.bid * NTHR + F.tid; idx < 24 * 4096; idx += F.G * NTHR) {
        const int chain = idx >> 12, e4 = (idx & 4095) * 4, d = e4 & 127;
        bf16_t* p = DS + (size_t)chain * 64 * 16384 + e4; const float* dc = DEC + (size_t)chain * 64 * 128 + d;
        const u32x2 w = *(const u32x2*)p; float t0 = bf_lo(w.x), t1 = bf_hi(w.x), t2 = bf_lo(w.y), t3 = bf_hi(w.y);
#pragma unroll 16
        for (int m = 1; m < 64; ++m) { const u32x2 x = *(const u32x2*)(p + (size_t)m * 16384); const f32x4 de = *(const f32x4*)(dc + m * 128);
            t0 = de[0] * t0 + bf_lo(x.x); t1 = de[1] * t1 + bf_hi(x.x); t2 = de[2] * t2 + bf_lo(x.y); t3 = de[3] * t3 + bf_hi(x.y);
            *(u32x2*)(p + (size_t)m * 16384) = (u32x2){cvt_pk_bf16(t0, t1), cvt_pk_bf16(t2, t3)}; }
    }
}
__device__ __forceinline__ void scan_pass3(const Frame& F, const float* hgrn_norm_g) {
    const bf16_t* Qg = (const bf16_t*)(F.ws + WS_R + R_Q); const bf16_t* Vg = (const bf16_t*)(F.ws + WS_R + R_V); const bf16_t* GT = (const bf16_t*)(F.ws + WS_R + R_GT);
    const _Float16* LF = (const _Float16*)(F.ws + WS_R + R_LF); const bf16_t* DS = (const bf16_t*)(F.ws + WS_R + R_DS); bf16_t* HM = (bf16_t*)(F.ws + WS_H);
    LAS unsigned char* lds = F.lds; LAS float* RED = (LAS float*)(lds + RED_OFF);
    const int wid = F.wid, lane = F.lane, r = lane & 15, q = lane >> 4;
    ScanPre pre, nxt;
    u32x2 Spre[8];
    if (F.bid < 12 * 64) { const int bh0 = F.bid >> 6, mp0 = F.bid & 63; scan_load<true>(F, pre, Qg, Vg, LF, (bh0 / 6) * 8192 + mp0 * 128, (bh0 % 6) * 128);
        const bf16_t* slot0 = DS + (size_t)((bh0 * 2) * 64 + mp0) * 16384;
#pragma unroll
        for (int dt = 0; dt < 8; ++dt) Spre[dt] = *(const u32x2*)(slot0 + (16 * wid + r) * 128 + 16 * dt + 4 * q); }
#pragma unroll 1
    for (int item = F.bid; item < 12 * 64; item += F.G) {
        const int bh = item >> 6, mphys = item & 63, b = bh / 6, h = bh % 6, rowbase = b * 8192 + mphys * 128;
        f32x4 oacc[2][4];
#pragma unroll
        for (int c = 0; c < 2; ++c)
#pragma unroll
            for (int j = 0; j < 4; ++j) oacc[c][j] = (f32x4){0.f, 0.f, 0.f, 0.f};
        float ld0 = 0.f, ld1 = 0.f;
        f32x4 Sacc[8];
#pragma unroll 1
        for (int k = 0; k < 4; ++k) {
            const int dir = k >> 1;
            const int k2 = (k + 1) & 3, item2 = k == 3 ? item + F.G : item; const bool has_next = item2 < 12 * 64;
            const int bh2 = item2 >> 6, mp2 = item2 & 63, dir2 = k2 >> 1, c2 = dir2 ? 1 - (k2 & 1) : (k2 & 1);
            const int nrow0 = (bh2 / 6) * 8192 + mp2 * 128 + 64 * c2, nhcol = (bh2 % 6) * 128;
            if ((k & 1) == 0) {
#pragma unroll
                for (int dt = 0; dt < 8; ++dt) { const u32x2 w = Spre[dt]; Sacc[dt] = (f32x4){bf_lo(w.x), bf_hi(w.x), bf_lo(w.y), bf_hi(w.y)};
                    *(LAS u32x2*)(lds + ST_OFF + ((16 * wid + r) * RS128 + 16 * dt + 4 * q) * 2) = w; }
            } else if (has_next) {
                const int chain2 = bh2 * 2 + dir2, m2 = dir2 ? 63 - mp2 : mp2;
                const bf16_t* slot2 = DS + (size_t)(chain2 * 64 + m2) * 16384;
#pragma unroll
                for (int dt = 0; dt < 8; ++dt) Spre[dt] = *(const u32x2*)(slot2 + (16 * wid + r) * 128 + 16 * dt + 4 * q);
            }
            scan_chunk<true>(F, pre, nxt, has_next, Qg, Vg, LF + (size_t)dir2 * MT * DH, nrow0, nhcol, dir != 0, Sacc, oacc[0], ld0, ld1);
            pre = nxt;
            if ((k & 1) == 0) {
#pragma unroll
                for (int j = 0; j < 4; ++j) { const f32x4 t = oacc[0][j]; oacc[0][j] = oacc[1][j]; oacc[1][j] = t; }
            }
        }
#pragma unroll
        for (int c = 0; c < 2; ++c)
#pragma unroll
            for (int j = 0; j < 4; ++j) { const f32x4 o = oacc[c][j]; float ss = o[0] * o[0] + o[1] * o[1] + o[2] * o[2] + o[3] * o[3]; ss += __shfl_xor(ss, 16); ss += __shfl_xor(ss, 32);
                if (q == 0) RED[(64 * c + 16 * j + r) * 8 + wid] = ss; }
        __syncthreads();
        const int col = h * 128 + 16 * wid + 4 * q; const f32x4 gn = *(const f32x4*)(hgrn_norm_g + col);
        u32x2 gtv[2][4];
#pragma unroll
        for (int c = 0; c < 2; ++c)
#pragma unroll
            for (int j = 0; j < 4; ++j) gtv[c][j] = *(const u32x2*)(GT + (size_t)(rowbase + 64 * c + 16 * j + r) * DH + col);
#pragma unroll
        for (int c = 0; c < 2; ++c)
#pragma unroll
            for (int j = 0; j < 4; ++j) { const int tok = 64 * c + 16 * j + r; const f32x4 s0 = *(const LAS f32x4*)(RED + tok * 8), s1 = *(const LAS f32x4*)(RED + tok * 8 + 4);
                const float ss = (s0[0] + s0[1]) + (s0[2] + s0[3]) + (s1[0] + s1[1]) + (s1[2] + s1[3]); const float rstd = 1.0f / sqrtf(ss * (1.0f / 128.0f) + EPS);
                const size_t row = (size_t)(rowbase + tok); const u32x2 gt = gtv[c][j]; const f32x4 o = oacc[c][j];
                const float y0 = o[0] * rstd * gn[0] * bf_lo(gt.x), y1 = o[1] * rstd * gn[1] * bf_hi(gt.x), y2 = o[2] * rstd * gn[2] * bf_lo(gt.y), y3 = o[3] * rstd * gn[3] * bf_hi(gt.y);
                *(u32x2*)(HM + row * D + 256 + col) = (u32x2){cvt_pk_bf16(y0, y1), cvt_pk_bf16(y2, y3)}; }
        __syncthreads();
    }
}

__device__ __forceinline__ void pool_phase(const Frame& F, const float* pool_w, const float* pool_scale) {
    const float* PP = (const float*)(F.ws + WS_R + R_PP); bf16_t* HM = (bf16_t*)(F.ws + WS_H);
    LAS float* PL = (LAS float*)F.lds; LAS float* YL = (LAS float*)(F.lds + 65536);
    const int tid = F.tid;
    for (int item = F.bid; item < 256; item += F.G) {
        const int rowbase = item * 64;
        __syncthreads();
#pragma unroll
        for (int i = 0; i < 8; ++i) { const int e = (tid + NTHR * i) * 4, t = e >> 8, ch = e & 255; *(LAS f32x4*)(PL + t * 256 + ch) = *(const f32x4*)(PP + (size_t)(rowbase + t) * 256 + ch); }
        __syncthreads();
#pragma unroll
        for (int i = 0; i < 8; ++i) { const int e = (tid + NTHR * i) * 4, t = e >> 8, ch = e & 255, g = ch >> 6, w = 2 << g; int lo = t - (w >> 1), hi = lo + w; lo = lo < 0 ? 0 : lo; hi = hi > 64 ? 64 : hi;
            f32x4 s = {0.f, 0.f, 0.f, 0.f};
            for (int p = lo; p < hi; ++p) s += *(const LAS f32x4*)(PL + p * 256 + ch);
            const float inv = 1.0f / (float)(hi - lo);
            *(LAS f32x4*)(YL + t * 260 + ch) = s * inv - *(const LAS f32x4*)(PL + t * 256 + ch); }
        __syncthreads();
        {
            const int g = tid >> 7, tq = (tid >> 3) & 15, dq = tid & 7;
            f32x4 a[4][2];
#pragma unroll
            for (int k = 0; k < 4; ++k) { a[k][0] = (f32x4){0.f, 0.f, 0.f, 0.f}; a[k][1] = a[k][0]; }
            const float* wp = pool_w + (size_t)g * 4096 + dq * 8;
#pragma unroll 4
            for (int c = 0; c < 64; ++c) { const f32x4 w0 = *(const f32x4*)(wp + c * 64), w1 = *(const f32x4*)(wp + c * 64 + 4);
#pragma unroll
                for (int k = 0; k < 4; ++k) { const float y = YL[(tq + 16 * k) * 260 + g * 64 + c]; a[k][0] += w0 * y; a[k][1] += w1 * y; } }
            const f32x4 s0 = *(const f32x4*)(pool_scale + g * 64 + dq * 8), s1 = *(const f32x4*)(pool_scale + g * 64 + dq * 8 + 4);
#pragma unroll
            for (int k = 0; k < 4; ++k) { const f32x4 x0 = a[k][0] * s0, x1 = a[k][1] * s1;
                u32x4 w; w.x = cvt_pk_bf16(x0[0], x0[1]); w.y = cvt_pk_bf16(x0[2], x0[3]); w.z = cvt_pk_bf16(x1[0], x1[1]); w.w = cvt_pk_bf16(x1[2], x1[3]);
                *(u32x4*)(HM + (size_t)(rowbase + tq + 16 * k) * D + g * 64 + dq * 8) = w; }
        }
    }
    __syncthreads();
}

__device__ __forceinline__ void gmlp_phase(const Frame& F, const float* ln_g, const float* ln_b, const float* b_s) {
    const bf16_t* U = (const bf16_t*)(F.ws + WS_R + R_U); const bf16_t* VG = (const bf16_t*)(F.ws + WS_R + R_VG); const bf16_t* WSB = (const bf16_t*)(F.ws + WS_WS); bf16_t* HM = (bf16_t*)(F.ws + WS_H);
    LAS unsigned char* lds = F.lds; constexpr int VNT_OFF = 0, WSL_OFF = 34816, STAT_OFF = 69632;
    LAS float* STAT = (LAS float*)(lds + STAT_OFF);
    const int tid = F.tid, wid = F.wid, lane = F.lane, r = lane & 15, q = lane >> 4;
    for (int item = F.bid; item < 256; item += F.G) {
        const int n = item >> 1, gh = item & 1, rowbase = n * 128;
        __syncthreads();
#pragma unroll 1
        for (int i0 = 0; i0 < 16; i0 += 4) {
            u32x4 ra[4], rb[4];
#pragma unroll
            for (int t = 0; t < 4; ++t) { const bf16_t* p = VG + (size_t)(rowbase + 16 * wid + i0 + t) * D + lane * 16; ra[t] = *(const u32x4*)p; rb[t] = *(const u32x4*)(p + 8); }
#pragma unroll
            for (int t = 0; t < 4; ++t) { const int tk = 16 * wid + i0 + t; float s = 0.f, ss = 0.f;
                const unsigned ws8[8] = {ra[t].x, ra[t].y, ra[t].z, ra[t].w, rb[t].x, rb[t].y, rb[t].z, rb[t].w};
#pragma unroll
                for (int k = 0; k < 8; ++k) { const float lo = bf_lo(ws8[k]), hi = bf_hi(ws8[k]); s += lo + hi; ss += lo * lo + hi * hi; }
#pragma unroll
                for (int o = 32; o >= 1; o >>= 1) { s += __shfl_xor(s, o); ss += __shfl_xor(ss, o); }
                const float mean = s * (1.0f / D); float var = ss * (1.0f / D) - mean * mean; var = var < 0.f ? 0.f : var;
                if (lane == 0) *(LAS f32x2*)(STAT + tk * 2) = (f32x2){mean, 1.0f / sqrtf(var + EPS)}; }
        }
        __syncthreads();
#pragma unroll 1
        for (int gi = 0; gi < 4; ++gi) {
            const int g = gh * 4 + gi;
#pragma unroll
            for (int i = 0; i < 4; ++i) { const int id = tid + NTHR * i, p = id >> 4, q8 = (id & 15) * 8; *(LAS u32x4*)(lds + WSL_OFF + (p * RS128 + q8) * 2) = *(const u32x4*)(WSB + (size_t)g * 16384 + p * 128 + q8); }
            {
                const int c0 = g * 128 + 2 * lane; const f32x2 lg = *(const f32x2*)(ln_g + c0), lb2 = *(const f32x2*)(ln_b + c0);
                unsigned lo8[8], hi8[8]; float pl = 0.f, ph = 0.f;
#pragma unroll
                for (int i = 0; i < 16; ++i) { const int tk = 16 * wid + i; const unsigned x = *(const unsigned*)(VG + (size_t)(rowbase + tk) * D + c0); const f32x2 st = *(const LAS f32x2*)(STAT + tk * 2);
                    const float y0 = (bf_lo(x) - st.x) * st.y * lg.x + lb2.x, y1 = (bf_hi(x) - st.x) * st.y * lg.y + lb2.y;
                    if (i & 1) { lo8[i >> 1] = cvt_pk_bf16(pl, y0); hi8[i >> 1] = cvt_pk_bf16(ph, y1); } else { pl = y0; ph = y1; } }
                *(LAS u32x4*)(lds + VNT_OFF + ((2 * lane) * RS128 + 16 * wid) * 2) = (u32x4){lo8[0], lo8[1], lo8[2], lo8[3]}; *(LAS u32x4*)(lds + VNT_OFF + ((2 * lane) * RS128 + 16 * wid + 8) * 2) = (u32x4){lo8[4], lo8[5], lo8[6], lo8[7]};
                *(LAS u32x4*)(lds + VNT_OFF + ((2 * lane + 1) * RS128 + 16 * wid) * 2) = (u32x4){hi8[0], hi8[1], hi8[2], hi8[3]}; *(LAS u32x4*)(lds + VNT_OFF + ((2 * lane + 1) * RS128 + 16 * wid + 8) * 2) = (u32x4){hi8[4], hi8[5], hi8[6], hi8[7]};
            }
            __syncthreads();
            f32x4 acc[8];
#pragma unroll
            for (int ct = 0; ct < 8; ++ct) acc[ct] = (f32x4){0.f, 0.f, 0.f, 0.f};
#pragma unroll
            for (int kt = 0; kt < 4; ++kt) { const bf16x8 Qf = *(const LAS bf16x8*)(lds + WSL_OFF + ((16 * wid + r) * RS128 + kt * 32 + 8 * q) * 2);
#pragma unroll
                for (int ct = 0; ct < 8; ++ct) { const bf16x8 P = *(const LAS bf16x8*)(lds + VNT_OFF + ((16 * ct + r) * RS128 + kt * 32 + 8 * q) * 2); acc[ct] = mfma16(P, Qf, acc[ct]); } __builtin_amdgcn_sched_barrier(0); }
            const int tk = 16 * wid + r; const float bs = b_s[g * 128 + tk]; const size_t rowo = (size_t)(rowbase + tk) * D + g * 128 + 4 * q;
            u32x2 uu[8];
#pragma unroll
            for (int ct = 0; ct < 8; ++ct) uu[ct] = *(const u32x2*)(U + rowo + 16 * ct);
#pragma unroll
            for (int ct = 0; ct < 8; ++ct) { const u32x2 u2 = uu[ct]; const f32x4 a = acc[ct];
                *(u32x2*)(HM + rowo + 16 * ct) = (u32x2){cvt_pk_bf16(bf_lo(u2.x) * (a[0] + bs), bf_hi(u2.x) * (a[1] + bs)), cvt_pk_bf16(bf_lo(u2.y) * (a[2] + bs), bf_hi(u2.y) * (a[3] + bs))}; }
            __syncthreads();
        }
    }
}

#define XB_TMO      128
#define XB_XCNT(j)  (256  + 64 * (j))
#define XB_XSUB(j)  (1280 + 64 * (j))
#define XB_XGEN(j)  (2304 + 64 * (j))
#define XB_TOP      3328
#define XB_TOPGEN   3392
#define XCD_BAR_WORDS 3456
#define XB_SPIN_CAP (1u << 18)

__device__ __forceinline__ unsigned xb_ld(unsigned* p)              { return __hip_atomic_load(p, __ATOMIC_RELAXED, __HIP_MEMORY_SCOPE_AGENT); }
__device__ __forceinline__ unsigned xb_add(unsigned* p, unsigned v) { return __hip_atomic_fetch_add(p, v, __ATOMIC_RELAXED, __HIP_MEMORY_SCOPE_AGENT); }
__device__ __forceinline__ unsigned xb_xcc_id() { return (unsigned)__builtin_amdgcn_s_getreg((3 << 11) | 20) & 0xFu; }
#define XB_SPIN(cond, bar) do { unsigned _sp = 0; while (cond) { __builtin_amdgcn_s_sleep(1); \
    if ((++_sp & 255u) == 0u) { if (xb_ld(&(bar)[XB_TMO])) break; if (_sp > XB_SPIN_CAP) { atomicAdd(&(bar)[XB_TMO], 1u); break; } } } } while (0)

struct XcdBarrier {
    unsigned* bar; unsigned x;
    volatile LAS unsigned* st;
};

__device__ __forceinline__ XcdBarrier xcd_barrier_post(unsigned* bar, volatile LAS unsigned* st) {
    XcdBarrier b; b.bar = bar; b.x = xb_xcc_id(); b.st = st;
    if (threadIdx.x == 0) (void)xb_add(&bar[XB_XCNT(b.x)], 1u);
    return b;
}
__device__ __forceinline__ void xcd_barrier_complete(unsigned* bar, unsigned x, unsigned& nloc, unsigned& nx) {
    const unsigned G = gridDim.x * gridDim.y * gridDim.z;
    unsigned sum, cnt, mine, sp = 0u;
    for (;;) {
        sum = 0u; cnt = 0u; mine = 0u;
#pragma unroll
        for (unsigned j = 0; j < 16; ++j) { const unsigned c = xb_ld(&bar[XB_XCNT(j)]); sum += c; cnt += (c > 0u) ? 1u : 0u; mine = (j == x) ? c : mine; }
        if (sum == G) break;
        __builtin_amdgcn_s_sleep(1);
        if ((++sp & 255u) == 0u) { if (xb_ld(&bar[XB_TMO])) break; if (sp > XB_SPIN_CAP) { atomicAdd(&bar[XB_TMO], 1u); break; } }
    }
    nloc = mine > 0u ? mine : 1u; nx = cnt > 0u ? cnt : 1u;
}

__device__ __forceinline__ void xcd_barrier(const XcdBarrier& b) {
    asm volatile("s_waitcnt vmcnt(0)" ::: "memory");
    __syncthreads();
    if (threadIdx.x == 0) {
        unsigned* bar = b.bar;
        __builtin_amdgcn_s_waitcnt(0);
        unsigned nloc = b.st[0], nx = b.st[1];
        if (nloc == 0u) { xcd_barrier_complete(bar, b.x, nloc, nx); b.st[0] = nloc; b.st[1] = nx; }
        const unsigned old = xb_add(&bar[XB_XSUB(b.x)], 1u);
        const unsigned gen = old / nloc;
        if (old + 1u == (gen + 1u) * nloc) {
            __builtin_amdgcn_fence(__ATOMIC_RELEASE, "agent");
            asm volatile("s_waitcnt vmcnt(0)" ::: "memory");
            const unsigned og = xb_add(&bar[XB_TOP], 1u);
            const unsigned tg = og / nx;
            if (og + 1u == (tg + 1u) * nx) xb_add(&bar[XB_TOPGEN], 1u);
            else XB_SPIN(xb_ld(&bar[XB_TOPGEN]) == tg, bar);
            __builtin_amdgcn_fence(__ATOMIC_ACQUIRE, "agent");
            xb_add(&bar[XB_XGEN(b.x)], 1u);
            asm volatile("s_waitcnt vmcnt(0)" ::: "memory");
        } else {
            XB_SPIN(xb_ld(&bar[XB_XGEN(b.x)]) == gen, bar);
            __builtin_amdgcn_fence(__ATOMIC_ACQUIRE, "agent");
            asm volatile("s_waitcnt vmcnt(0)" ::: "memory");
        }
    }
    __syncthreads();
}

__global__ void __launch_bounds__(NTHR) mega_fwd(Args args) {
    extern __shared__ __attribute__((aligned(16))) unsigned char lds_raw[];
    cg::grid_group grid = cg::this_grid();
    Frame F;
    F.lds = (LAS unsigned char*)lds_raw; F.tid = threadIdx.x; F.lane = F.tid & 63; F.wid = __builtin_amdgcn_readfirstlane(F.tid >> 6); F.G = gridDim.x; F.bid = blockIdx.x;
    F.out = args.out; F.ws = args.ws;
    unsigned char* ws = F.ws;
    float* XL = F.out; float* XC = (float*)(ws + WS_XC); bf16_t* H = (bf16_t*)(ws + WS_H); bf16_t* G = (bf16_t*)(ws + WS_R + R_G);
    const float* MOD0 = (const float*)(ws + WS_MOD); const float* MOD1 = MOD0 + 3 * NMODD;
    const int lo = args.ph_lo, hi = args.ph_hi;
    if (lo < -1) grid.sync();
    volatile LAS unsigned* bst = (volatile LAS unsigned*)(F.lds + LDS_BYTES - 16);
    if (F.tid < 4) bst[F.tid] = 0u;
    __syncthreads();
    const XcdBarrier xbar = xcd_barrier_post((unsigned*)(ws + WS_BAR), bst);
#define IN(k) (lo <= (k) && (k) < hi)
#ifndef PROBE_MASK
#define PROBE_MASK 0u
#endif
#ifndef PROBE_SCALE
#define PROBE_SCALE 1.0f
#endif
    unsigned long long* TS = (unsigned long long*)(ws + 2048);
    const bool stamper = PROBE_MASK != 0u && F.bid == 0 && F.tid == 0;
    if (stamper) TS[0] = __builtin_amdgcn_s_memrealtime();
#define SEAM(k) do { if (IN(k) && IN((k) + 1)) { xcd_barrier(xbar); } if (stamper) TS[(k) + 1] = __builtin_amdgcn_s_memrealtime(); } while (0)
    if (IN(0)) mod_phase(F, args.in[1], args.in[3], args.in[4], args.in[5], args.in[19]); SEAM(0);
    if (IN(1)) { norm_phase(F, args.in[0], args.in[2], MT, args.in[6] + 0 * D, MOD0, 0, H); run_tjobs(F, args, 0, 0x13u, 0, F.G); } SEAM(1);
    if (IN(2)) { run_gemm(F, H, (const bf16_t*)(ws + WS_UP0), MT, 2 * DFF, D, EpiSwiGlu{G}); run_tjobs(F, args, 0, 0x40u, 172, F.G - 172); } SEAM(2);
    if (IN(3)) { run_gemm(F, G, (const bf16_t*)(ws + WS_DN0), ML, D, DFF, EpiResid{args.in[0], args.in[2], XL, XC, MOD0 + 2 * 1024, 0.5f});
        run_ctx_down_splitk(F, G + (size_t)ML * DFF, (const bf16_t*)(ws + WS_DN0), (float*)(ws + WS_R + R_PART)); } SEAM(3);
    if (IN(4)) norm_phase(F, XL, args.in[2], MT, args.in[6] + 1 * D, MOD0, 1, H, (const float*)(ws + WS_R + R_PART), MOD0 + 2 * NMODD + 2 * 1024); SEAM(4);
    if (IN(5)) { run_gemm(F, H, (const bf16_t*)(ws + WS_WIN), MT, DIN, D, EpiWin{ws + WS_R, args.in[13]}); run_tjobs(F, args, 0, 0x3ACu, 32, F.G - 32); } SEAM(5);
    if (IN(6)) scan_pass1(F); SEAM(6);
    if (IN(7)) { scan_pass2(F); pool_phase(F, args.in[11], args.in[12]); } SEAM(7);
    if (IN(8)) scan_pass3(F, args.in[14]); SEAM(8);
    if (IN(9)) run_gemm(F, H, (const bf16_t*)(ws + WS_WOUT), ML, D, D, EpiResid{XL, XC, XL, XC, MOD0 + 5 * 1024, 1.0f}); SEAM(9);
    if (IN(10)) norm_phase(F, XL, XC, ML, args.in[6] + 2 * D, MOD0, 2, H); SEAM(10);
    if (IN(11)) { run_gemm(F, H, (const bf16_t*)(ws + WS_UP0 + SZ_UP), ML, 2 * DFF, D, EpiSwiGlu{G}); run_tjobs(F, args, 1, 0x13u, 128, F.G - 128); } SEAM(11);
    if (IN(12)) run_gemm(F, G, (const bf16_t*)(ws + WS_DN0 + SZ_DN), ML, D, DFF, EpiResid{XL, XC, XL, XC, MOD0 + 8 * 1024, 0.5f}); SEAM(12);
    if (IN(13)) norm_phase(F, XL, XC, ML, args.in[6] + 3 * D, MOD1, 0, H); SEAM(13);
    if (IN(14)) { run_gemm(F, H, (const bf16_t*)(ws + WS_R + R_UP1), ML, 2 * DFF, D, EpiSwiGlu{G}); run_tjobs(F, args, 1, 0x2Cu, 128, F.G - 128); } SEAM(14);
    if (IN(15)) run_gemm(F, G, (const bf16_t*)(ws + WS_R + R_DN1), ML, D, DFF, EpiResid{XL, XC, XL, XC, MOD1 + 2 * 1024, 0.5f}); SEAM(15);
    if (IN(16)) norm_phase(F, XL, XC, ML, args.in[6] + 4 * D, MOD1, 1, H); SEAM(16);
    if (IN(17)) run_gemm(F, H, (const bf16_t*)(ws + WS_GIN), ML, 2 * D, D, EpiGin{(bf16_t*)(ws + WS_R + R_U), (bf16_t*)(ws + WS_R + R_VG)}); SEAM(17);
    if (IN(18)) gmlp_phase(F, args.in[17], args.in[18], args.in[20]); SEAM(18);
    if (IN(19)) run_gemm(F, H, (const bf16_t*)(ws + WS_GOUT), ML, D, D, EpiResid{XL, XC, XL, XC, MOD1 + 5 * 1024, 1.0f}); SEAM(19);
    if (IN(20)) norm_phase(F, XL, XC, ML, args.in[6] + 5 * D, MOD1, 2, H); SEAM(20);
    if (IN(21)) run_gemm(F, H, (const bf16_t*)(ws + WS_R + R_UP1 + SZ_UP), ML, 2 * DFF, D, EpiSwiGlu{G}); SEAM(21);
    if (IN(22)) run_gemm(F, G, (const bf16_t*)(ws + WS_R + R_DN1 + SZ_DN), ML, D, DFF, EpiResid{XL, XC, XL, XC, MOD1 + 8 * 1024, 0.5f}); SEAM(22);
    if (IN(23)) final_norm_phase(F, XL, args.in[22]);
    if (PROBE_MASK != 0u && F.bid == 0) { __syncthreads(); if (F.tid == 0) { TS[24] = __builtin_amdgcn_s_memrealtime(); unsigned long long tot = 0;
        for (int k = 0; k < 24; ++k) if ((PROBE_MASK >> k) & 1u) tot += TS[k + 1] - TS[k];
        F.out[0] = (float)tot * 1e-5f * PROBE_SCALE; } }
}
constexpr int NPHASES = 24;
#ifndef MK_PER_PHASE
#define MK_PER_PHASE 0
#endif

extern "C" void kernel_launch(void* const* d_in, const int* in_sizes, int n_in, void* d_out, int out_size, void* d_ws, size_t ws_size, hipStream_t stream) {
    static int grid = 0;
    if (grid == 0) {
        if (n_in != 23 || out_size != ML * D || ws_size < WS_END) { fprintf(stderr, "kernel_launch: unexpected shapes (n_in %d out %d ws %zu need %zu)\n", n_in, out_size, ws_size, (size_t)WS_END); grid = -1; return; }
        int dev = 0, cus = 0, per_cu = 0;
        hipGetDevice(&dev); hipDeviceGetAttribute(&cus, hipDeviceAttributeMultiprocessorCount, dev);
        hipFuncSetAttribute((const void*)mega_fwd, hipFuncAttributeMaxDynamicSharedMemorySize, LDS_BYTES);
        hipOccupancyMaxActiveBlocksPerMultiprocessor(&per_cu, (const void*)mega_fwd, NTHR, LDS_BYTES);
        if (per_cu < 1) { fprintf(stderr, "kernel_launch: occupancy query says %d blocks per CU\n", per_cu); per_cu = 1; }
        (void)hipGetLastError();
        grid = cus;
    }
    if (grid < 0) return;
    if (hipMemsetAsync((unsigned char*)d_ws + WS_BAR, 0, XCD_BAR_WORDS * 4, stream) != hipSuccess) { fprintf(stderr, "kernel_launch: memset failed\n"); return; }
    Args a{};
    for (int i = 0; i < 23; ++i) a.in[i] = (const float*)d_in[i];
    a.out = (float*)d_out; a.ws = (unsigned char*)d_ws;
#if MK_PER_PHASE
    for (int p = 0; p < NPHASES; ++p) { a.ph_lo = p; a.ph_hi = p + 1; hipLaunchKernelGGL(mega_fwd, dim3(grid), dim3(NTHR), LDS_BYTES, stream, a); }
#else
    a.ph_lo = 0; a.ph_hi = NPHASES;
    void* kargs[] = {&a};
    hipError_t e = hipLaunchCooperativeKernel((const void*)mega_fwd, dim3(grid), dim3(NTHR), kargs, LDS_BYTES, stream);
    if (e != hipSuccess) fprintf(stderr, "kernel_launch: cooperative launch failed: %s (grid %d)\n", hipGetErrorString(e), grid);
#endif
}
```
